# Optimizing an MI355X kernel written in HIP

```python
import jax, jax.numpy as jnp
from jax import lax
import numpy as np

D_MODEL = 1024
BATCH = 16
SEQ = 2048
DEPTH = 4
DEC_BATCH = 8
DEC_SEQ = 64
PAST_LEN = 1024

CHUNK = 64
N_EVEN = (DEPTH + 1) // 2
N_ODD = DEPTH // 2
EPS = 1e-6
ATTN_DIM = D_MODEL // 2
N_HEADS_A = 8
HEAD_DIM = ATTN_DIM // N_HEADS_A
N_KV_A = 2
GQA_REP = N_HEADS_A // N_KV_A
KV_DIM = N_KV_A * HEAD_DIM
N_IDX_HEADS = 8
IDX_DIM = 64
TOPK_MAX = 256
Q_BLOCK = 128
CONV_DIM = D_MODEL // 2
CONV_W = 3
SGU_DIM = D_MODEL
SGU_CHUNK = 128
N_SGU_GROUPS = 8
SGU_GROUP_CH = SGU_DIM // N_SGU_GROUPS

EVEN_SPLITS = (ATTN_DIM, KV_DIM, KV_DIM, ATTN_DIM, N_IDX_HEADS * IDX_DIM, IDX_DIM, N_IDX_HEADS,
               CONV_DIM, CONV_DIM, CONV_DIM, CONV_DIM)
EVEN_IN = sum(EVEN_SPLITS)
ODD_IN = 3 * SGU_DIM

kernel_name = "dsa_shortconv_sgu_streaming_step"


def _split(t, sizes):
    cuts = [int(i) for i in np.cumsum(sizes)[:-1]]
    return jnp.split(t, cuts, axis=-1)


def _rmsnorm(x, g):
    xf = x.astype(jnp.float32)
    y = xf * lax.rsqrt(jnp.mean(xf * xf, axis=-1, keepdims=True) + EPS)
    return (y * g.astype(jnp.float32)).astype(x.dtype)


def _layernorm(x, g, b):
    xf = x.astype(jnp.float32)
    mu = jnp.mean(xf, axis=-1, keepdims=True)
    xc = xf - mu
    y = xc * lax.rsqrt(jnp.mean(xc * xc, axis=-1, keepdims=True) + EPS)
    return (y * g.astype(jnp.float32) + b.astype(jnp.float32)).astype(x.dtype)


def _dsa_block(q, qi, wi, qpos, k, v, ki, kpos, topk):
    rel = jax.nn.relu(jnp.einsum('bqhd,bsd->bqhs', qi, ki)).astype(jnp.float32)
    score = jnp.einsum('bqh,bqhs->bqs', wi.astype(jnp.float32), rel)
    adm = (kpos[None, :] // CHUNK) <= (qpos[:, None] // CHUNK)
    score = jnp.where(adm[None], score, -jnp.inf)
    top_val, top_idx = lax.top_k(score, topk)
    valid = jnp.isfinite(top_val)
    gather = jax.vmap(lambda a, i: a[i])
    kg = gather(k, top_idx)
    vg = gather(v, top_idx)
    logits = jnp.einsum('bqgrd,bqkgd->bqgrk', q, kg).astype(jnp.float32) * (HEAD_DIM ** -0.5)
    logits = jnp.where(valid[:, :, None, None, :], logits, -jnp.inf)
    p = jax.nn.softmax(logits, axis=-1).astype(v.dtype)
    return jnp.einsum('bqgrk,bqkgd->bqgrd', p, vg)


def _even_mixer(h, w_in, conv_w, w_out, past_k, past_v, past_ki, conv_hist):
    nb, T, _ = h.shape
    q, k, v, ga, qi, ki, wi, gb, gc, xin, gz = _split(h @ w_in, EVEN_SPLITS)
    q = q.reshape(nb, T, N_KV_A, GQA_REP, HEAD_DIM)
    k = k.reshape(nb, T, N_KV_A, HEAD_DIM)
    v = v.reshape(nb, T, N_KV_A, HEAD_DIM)
    qi = qi.reshape(nb, T, N_IDX_HEADS, IDX_DIM)
    if past_k is None:
        P = 0
        keys, vals, kidx = k, v, ki
        hist = jnp.zeros((nb, CONV_W - 1, CONV_DIM), h.dtype)
    else:
        P = past_k.shape[1]
        keys = jnp.concatenate([past_k.astype(k.dtype), k], axis=1)
        vals = jnp.concatenate([past_v.astype(v.dtype), v], axis=1)
        kidx = jnp.concatenate([past_ki.astype(ki.dtype), ki], axis=1)
        hist = conv_hist.astype(h.dtype)
    L = P + T
    kpos = jnp.arange(L, dtype=jnp.int32)
    qpos = P + jnp.arange(T, dtype=jnp.int32)
    topk = min(TOPK_MAX, L // 4)
    if T > Q_BLOCK:
        nblk = T // Q_BLOCK
        def blk(a):
            return jnp.moveaxis(a.reshape((nb, nblk, Q_BLOCK) + a.shape[2:]), 1, 0)
        o = lax.map(lambda xs: _dsa_block(xs[0], xs[1], xs[2], xs[3], keys, vals, kidx, kpos, topk),
                    (blk(q), blk(qi), blk(wi), qpos.reshape(nblk, Q_BLOCK)))
        o = jnp.moveaxis(o, 0, 1).reshape(nb, T, ATTN_DIM)
    else:
        o = _dsa_block(q, qi, wi, qpos, keys, vals, kidx, kpos, topk).reshape(nb, T, ATTN_DIM)
    a_out = o * jax.nn.silu(ga)
    z = gc * xin
    zp = jnp.concatenate([hist, z], axis=1)
    y = conv_w[CONV_W - 1] * zp[:, CONV_W - 1:]
    for j in range(CONV_W - 1):
        y = y + conv_w[j] * zp[:, j:j + T]
    b_out = gb * y * jax.nn.silu(gz)
    out = jnp.concatenate([a_out, b_out], axis=-1) @ w_out
    return out, k, v, ki, zp[:, -(CONV_W - 1):]


def _odd_mixer(h, w_in, ws, bs, ln_g, ln_b, w_out):
    nb, T, _ = h.shape
    u, v, g = _split(h @ w_in, (SGU_DIM, SGU_DIM, SGU_DIM))
    u = jax.nn.gelu(u)
    v = _layernorm(jax.nn.gelu(v), ln_g, ln_b)
    if T >= SGU_CHUNK:
        nc, lc = T // SGU_CHUNK, SGU_CHUNK
    else:
        nc, lc = 1, T
    vc = v.reshape(nb, nc, lc, N_SGU_GROUPS, SGU_GROUP_CH)
    wm = jnp.tril(ws[:, :lc, :lc])
    s = jnp.einsum('gij,bnjgc->bnigc', wm, vc) + bs[:, :lc].T[None, None, :, :, None]
    s = s.reshape(nb, T, SGU_DIM)
    out = (u * s * jax.nn.silu(g)) @ w_out
    return out, v


def _trunk(x, c, ada_w, ada_b, norm_g, ev_w_in, ev_conv_w, ev_w_out, od_w_in, od_ws, od_bs, od_ln_g, od_ln_b,
           od_w_out, final_g, cache_k=None, cache_v=None, cache_ki=None, conv_state=None):
    ks, vs, kis, convs, cvs = [], [], [], [], []
    cs = jax.nn.silu(c)
    for l in range(DEPTH):
        shift, scale, gate = jnp.split(cs @ ada_w[l] + ada_b[l], 3, axis=-1)
        h = _rmsnorm(x, norm_g[l]) * (1 + scale[:, None]) + shift[:, None]
        if l % 2 == 0:
            e = l // 2
            if cache_k is None:
                hist = (None, None, None, None)
            else:
                hist = (cache_k[e], cache_v[e], cache_ki[e], conv_state[e])
            out, k, v, ki, cst = _even_mixer(h, ev_w_in[e], ev_conv_w[e], ev_w_out[e], *hist)
            ks.append(k); vs.append(v); kis.append(ki); convs.append(cst)
        else:
            o = l // 2
            out, vrow = _odd_mixer(h, od_w_in[o], od_ws[o], od_bs[o], od_ln_g[o], od_ln_b[o], od_w_out[o])
            cvs.append(vrow)
        x = x + gate[:, None] * out
    new_c = None if cache_k is None else jnp.stack(cvs)
    return _rmsnorm(x, final_g), jnp.stack(ks), jnp.stack(vs), jnp.stack(kis), jnp.stack(convs), new_c


def setup_inputs(seed: int = 0) -> dict:
    key = jax.random.key(seed)
    k = jax.random.split(key, 21)
    def nrm(kk, shape, s):
        return jax.random.normal(kk, shape, jnp.float32) * s
    return {
        "x_prompt": nrm(k[0], (BATCH, SEQ, D_MODEL), 1.0),
        "x_sample": nrm(k[1], (DEC_BATCH, DEC_SEQ, D_MODEL), 1.0),
        "cache_a_k": nrm(k[2], (N_EVEN, DEC_BATCH, PAST_LEN, N_KV_A, HEAD_DIM), 1.0),
        "cache_a_v": nrm(k[3], (N_EVEN, DEC_BATCH, PAST_LEN, N_KV_A, HEAD_DIM), 1.0),
        "cache_a_kidx": nrm(k[4], (N_EVEN, DEC_BATCH, PAST_LEN, IDX_DIM), 1.0),
        "state_b_conv": nrm(k[5], (N_EVEN, DEC_BATCH, CONV_W - 1, CONV_DIM), 1.0),
        "c_prompt": nrm(k[6], (BATCH, D_MODEL), 1.0),
        "c_sample": nrm(k[7], (DEC_BATCH, D_MODEL), 1.0),
        "ada_w": nrm(k[8], (DEPTH, D_MODEL, 3 * D_MODEL), 0.5 * D_MODEL ** -0.5),
        "ada_b": nrm(k[9], (DEPTH, 3 * D_MODEL), 0.02),
        "norm_g": 1.0 + nrm(k[10], (DEPTH, D_MODEL), 0.02),
        "ev_w_in": nrm(k[11], (N_EVEN, D_MODEL, EVEN_IN), D_MODEL ** -0.5),
        "ev_conv_w": nrm(k[12], (N_EVEN, CONV_W, CONV_DIM), CONV_W ** -0.5),
        "ev_w_out": nrm(k[13], (N_EVEN, ATTN_DIM + CONV_DIM, D_MODEL), (ATTN_DIM + CONV_DIM) ** -0.5),
        "od_w_in": nrm(k[14], (N_ODD, D_MODEL, ODD_IN), D_MODEL ** -0.5),
        "od_ws": nrm(k[15], (N_ODD, N_SGU_GROUPS, SGU_CHUNK, SGU_CHUNK), 0.5 * SGU_CHUNK ** -0.5),
        "od_bs": 1.0 + nrm(k[16], (N_ODD, N_SGU_GROUPS, SGU_CHUNK), 0.1),
        "od_ln_g": 1.0 + nrm(k[17], (N_ODD, SGU_DIM), 0.02),
        "od_ln_b": nrm(k[18], (N_ODD, SGU_DIM), 0.02),
        "od_w_out": nrm(k[19], (N_ODD, SGU_DIM, D_MODEL), SGU_DIM ** -0.5),
        "final_g": 1.0 + nrm(k[20], (D_MODEL,), 0.02),
    }


def reference(x_prompt, x_sample, cache_a_k, cache_a_v, cache_a_kidx, state_b_conv, c_prompt, c_sample,
              ada_w, ada_b, norm_g, ev_w_in, ev_conv_w, ev_w_out, od_w_in, od_ws, od_bs, od_ln_g, od_ln_b,
              od_w_out, final_g):
    y_prompt, k_p, v_p, ki_p, conv_p, _ = _trunk(
        x_prompt, c_prompt, ada_w, ada_b, norm_g, ev_w_in, ev_conv_w, ev_w_out, od_w_in, od_ws, od_bs,
        od_ln_g, od_ln_b, od_w_out, final_g)
    y_sample, k_s, v_s, ki_s, conv_s, cv_s = _trunk(
        x_sample, c_sample, ada_w, ada_b, norm_g, ev_w_in, ev_conv_w, ev_w_out, od_w_in, od_ws, od_bs,
        od_ln_g, od_ln_b, od_w_out, final_g, cache_a_k, cache_a_v, cache_a_kidx, state_b_conv)
    return (y_prompt, y_sample, k_p, v_p, ki_p, conv_p, k_s, v_s, ki_s, conv_s, cv_s)
```

```cpp
#include <hip/hip_runtime.h>
#include <hip/hip_cooperative_groups.h>
#include <cstdio>
namespace cg = cooperative_groups;

#ifndef REPEAT_KINDS
#define REPEAT_KINDS 0
#endif
#ifndef ATT_REP
#define ATT_REP 0
#endif
#ifndef GEMM_REP
#define GEMM_REP 0
#endif
#ifndef ONE_LAUNCH
#define ONE_LAUNCH 1
#endif

typedef unsigned short u16;
typedef unsigned long long u64;
typedef __attribute__((ext_vector_type(8))) short bf16x8;
typedef __attribute__((ext_vector_type(16))) float f32x16;
typedef __attribute__((ext_vector_type(4))) float f32x4;
#define DI __device__ __forceinline__
#define MFMA32(a, b, c) __builtin_amdgcn_mfma_f32_32x32x16_bf16((a), (b), (c), 0, 0, 0)
#define MFMA16(a, b, c) __builtin_amdgcn_mfma_f32_16x16x32_bf16((a), (b), (c), 0, 0, 0)

constexpr int D = 1024;
constexpr int NTOK_P = 32768, NTOK_S = 512, NTOK = NTOK_P + NTOK_S;
constexpr int WE_ROWS = 4096;
constexpr int PSE = 2560;
constexpr int C_Q = 0, C_GA = 512, C_QI = 1024, C_Z = 1536, C_GBZ = 2048;
constexpr int WO_ROWS = 3072;
constexpr int PSO = 2048;
constexpr int KROWS = 32768 + 8 * 1088;
constexpr int NTHREADS = 512;
constexpr int MAXGRID = 256;

constexpr size_t O_Y = 0, O_KP = 34078720, O_VP = 42467328, O_KIP = 50855936, O_CVP = 55050240, O_KS = 55083008,
                 O_VS = 55214080, O_KIS = 55345152, O_CVS = 55410688, O_CV = 55427072;

constexpr size_t XCD_BAR_BYTES = 3456 * 4;
constexpr size_t WS_MOD = 0;
constexpr size_t WS_WI = WS_MOD + 4ull * 24 * 3072 * 4;
constexpr size_t WS_WSB = WS_WI + (size_t)NTOK * 8 * 4;
constexpr size_t WS_WEIN = WS_WSB + 2ull * 8 * 128 * 128 * 2;
constexpr size_t WS_WEOUT = WS_WEIN + 2ull * WE_ROWS * 1024 * 2;
constexpr size_t WS_WOIN = WS_WEOUT + 2ull * 1024 * 1024 * 2;
constexpr size_t WS_WOOUT = WS_WOIN + 2ull * 3072 * 1024 * 2;
constexpr size_t WS_KB = WS_WOOUT + 2ull * 1024 * 1024 * 2;
constexpr size_t WS_VT = WS_KB + 2ull * KROWS * 128 * 2;
constexpr size_t WS_KI = WS_VT + 2ull * KROWS * 128 * 2;
constexpr size_t WS_H = WS_KI + 2ull * KROWS * 64 * 2;
constexpr size_t WS_SC = WS_H + (size_t)NTOK * 1024 * 2;
constexpr size_t WS_P = WS_SC + (size_t)MAXGRID * 64 * 2048 * 2;
constexpr size_t WS_CTR = WS_P + (size_t)NTOK * 3072 * 2;
constexpr size_t WS_BAR = WS_CTR + 256;
constexpr size_t WS_END = WS_BAR + XCD_BAR_BYTES;

constexpr int LDS_BYTES = 148 * 1024;

struct Params {
  const float* in[21];
  float* out;
  unsigned char* ws;
};
struct Blk { int bid, nb; };
typedef const __attribute__((address_space(4))) unsigned char* kaptr;
struct PV {
  kaptr k;
  DI const float* inp(int i) const { return *(const float* const __attribute__((address_space(4)))*)(k + 8 * i); }
  DI float* outp() const { return *(float* const __attribute__((address_space(4)))*)(k + 8 * 21); }
  DI unsigned char* wsp() const { return *(unsigned char* const __attribute__((address_space(4)))*)(k + 8 * 22); }
};
enum { I_XP = 0, I_XS, I_CK, I_CV, I_CKI, I_SCONV, I_CP, I_CS, I_ADAW, I_ADAB, I_NORMG, I_EVWIN, I_EVCONV, I_EVWOUT, I_ODWIN, I_ODWS, I_ODBS, I_ODLNG, I_ODLNB, I_ODWOUT, I_FINALG };

DI u16 f2bf(float x) { __bf16 b = (__bf16)x; return __builtin_bit_cast(u16, b); }
DI float bf2f(u16 h) { return __uint_as_float(((unsigned)h) << 16); }
DI unsigned pack2(float a, float b) { return (unsigned)f2bf(a) | ((unsigned)f2bf(b) << 16); }
DI float silu_f(float x) { return x * __builtin_amdgcn_rcpf(1.f + __expf(-x)); }
DI float gelu_f(float x) {
  float u = 0.7978845608028654f * (x + 0.044715f * x * x * x);
  float t = 1.f - 2.f * __builtin_amdgcn_rcpf(__expf(2.f * u) + 1.f);
  return 0.5f * x * (1.f + t);
}
DI int mod_row(int tok) { return tok < NTOK_P ? (tok >> 11) : 16 + ((tok - NTOK_P) >> 6); }
DI int key_row(int tok) { return tok < NTOK_P ? tok : NTOK_P + ((tok - NTOK_P) >> 6) * 1088 + 1024 + ((tok - NTOK_P) & 63); }
DI float wave_sum(float v) {
#pragma unroll
  for (int o = 32; o > 0; o >>= 1) v += __shfl_xor(v, o);
  return v;
}

template <class Map>
DI void transpose_tile(const float* __restrict__ src, int ldsrc, u16* __restrict__ dst, int n0, int k0, Map map, float* tile, int tid) {
  const int c = tid & 63, r0 = tid >> 6;
  const int sc = map(n0 + c);
#pragma unroll
  for (int i = 0; i < 8; ++i) {
    const int r = r0 + 8 * i;
    tile[c * 65 + r] = sc >= 0 ? src[(size_t)(k0 + r) * ldsrc + sc] : 0.f;
  }
  __syncthreads();
  const int n = tid >> 3, ch = tid & 7;
  const float* t = tile + n * 65 + ch * 8;
  uint4 v;
  v.x = pack2(t[0], t[1]); v.y = pack2(t[2], t[3]); v.z = pack2(t[4], t[5]); v.w = pack2(t[6], t[7]);
  *(uint4*)(dst + (size_t)(n0 + n) * 1024 + k0 + ch * 8) = v;
  __syncthreads();
}

struct MapEvenIn { DI int operator()(int n) const {
  if (n < 1864) return n;
  if (n < 2048) return -1;
  const int m = n - 2048, j = (m >> 8) & 3, w = m & 255;
  if (m < 1024) return w < 128 ? 2376 + j * 128 + w : 2888 + j * 128 + (w - 128);
  return w < 128 ? 1864 + j * 128 + w : 3400 + j * 128 + (w - 128);
} };
struct MapOddIn { DI int operator()(int n) const {
  if (n < 2048) { const int j = n >> 8, w = n & 255; return w < 128 ? j * 128 + w : 2048 + j * 128 + (w - 128); }
  return 1024 + (n - 2048);
} };
struct MapId { DI int operator()(int n) const { return n; } };

DI void phase_prologue(const PV& p, Blk B, unsigned char* lds, int tid) {
  const int nb = B.nb, bid = B.bid;
  float* ldsf = (float*)lds;
  constexpr int N_MOD = 192;
  constexpr int T_EIN = 64 * 16;
  constexpr int T_EOUT = 16 * 16;
  constexpr int T_OIN = 48 * 16;
  constexpr int T_OOUT = 16 * 16;
  constexpr int N_T = 2 * (T_EIN + T_EOUT + T_OIN + T_OOUT);
  for (int it = bid; it < N_MOD + N_T; it += nb) {
    if (it < N_MOD) {
      const int l = it / 48, cc = it % 48;
      for (int i = tid; i < 24 * 1024; i += NTHREADS) {
        const int r = i >> 10, k = i & 1023;
        const float c = r < 16 ? p.inp(I_CP)[r * 1024 + k] : p.inp(I_CS)[(r - 16) * 1024 + k];
        ldsf[i] = silu_f(c);
      }
      __syncthreads();
      const int kg = tid >> 6, nl = tid & 63;
      float acc[24];
#pragma unroll
      for (int r = 0; r < 24; ++r) acc[r] = 0.f;
      const float* w = p.inp(I_ADAW) + (size_t)l * 1024 * 3072 + cc * 64 + nl;
      for (int k = kg * 128; k < kg * 128 + 128; k += 8) {
        float wv[8];
#pragma unroll
        for (int u = 0; u < 8; ++u) wv[u] = w[(size_t)(k + u) * 3072];
#pragma unroll
        for (int u = 0; u < 8; ++u)
#pragma unroll
          for (int r = 0; r < 24; ++r) acc[r] += ldsf[r * 1024 + k + u] * wv[u];
      }
      __syncthreads();
#pragma unroll
      for (int r = 0; r < 24; ++r) ldsf[(kg * 24 + r) * 64 + nl] = acc[r];
      __syncthreads();
      for (int i = tid; i < 24 * 64; i += NTHREADS) {
        const int r = i >> 6, n = i & 63;
        float s = 0.f;
#pragma unroll
        for (int g = 0; g < 8; ++g) s += ldsf[(g * 24 + r) * 64 + n];
        const int col = cc * 64 + n;
        ((float*)(p.wsp() + WS_MOD))[((size_t)l * 24 + r) * 3072 + col] = s + p.inp(I_ADAB)[l * 3072 + col];
      }
      __syncthreads();
    } else {
      int t = it - N_MOD;
      const int e = t / (T_EIN + T_EOUT + T_OIN + T_OOUT);
      t -= e * (T_EIN + T_EOUT + T_OIN + T_OOUT);
      if (t < T_EIN) {
        transpose_tile(p.inp(I_EVWIN) + (size_t)e * 1024 * 3912, 3912, (u16*)(p.wsp() + WS_WEIN) + (size_t)e * WE_ROWS * 1024, (t >> 4) * 64, (t & 15) * 64, MapEvenIn(), ldsf, tid);
      } else if ((t -= T_EIN) < T_EOUT) {
        transpose_tile(p.inp(I_EVWOUT) + (size_t)e * 1024 * 1024, 1024, (u16*)(p.wsp() + WS_WEOUT) + (size_t)e * 1024 * 1024, (t >> 4) * 64, (t & 15) * 64, MapId(), ldsf, tid);
      } else if ((t -= T_EOUT) < T_OIN) {
        transpose_tile(p.inp(I_ODWIN) + (size_t)e * 1024 * 3072, 3072, (u16*)(p.wsp() + WS_WOIN) + (size_t)e * 3072 * 1024, (t >> 4) * 64, (t & 15) * 64, MapOddIn(), ldsf, tid);
      } else {
        t -= T_OIN;
        transpose_tile(p.inp(I_ODWOUT) + (size_t)e * 1024 * 1024, 1024, (u16*)(p.wsp() + WS_WOOUT) + (size_t)e * 1024 * 1024, (t >> 4) * 64, (t & 15) * 64, MapId(), ldsf, tid);
      }
    }
  }
  const int gt = bid * NTHREADS + tid, gs = nb * NTHREADS;
  if (gt < 64) ((unsigned*)(p.wsp() + WS_CTR))[gt] = 0u;
  {
    u16* wsb = (u16*)(p.wsp() + WS_WSB);
    for (int i = gt; i < 2 * 8 * 128 * 128; i += gs) {
      const int jj = i & 127, ii = (i >> 7) & 127;
      wsb[i] = f2bf(jj <= ii ? p.inp(I_ODWS)[i] : 0.f);
    }
  }
  {
    u16* kb = (u16*)(p.wsp() + WS_KB);
    for (int i = gt; i < 2 * 8 * 1024 * 16; i += gs) {
      const int c8 = i & 15, pos = (i >> 4) & 1023, b = (i >> 14) & 7, e = i >> 17;
      const float* s = p.inp(I_CK) + (size_t)i * 8;
      const float4 a = *(const float4*)s, bb = *(const float4*)(s + 4);
      uint4 v; v.x = pack2(a.x, a.y); v.y = pack2(a.z, a.w); v.z = pack2(bb.x, bb.y); v.w = pack2(bb.z, bb.w);
      *(uint4*)(kb + ((size_t)e * KROWS + NTOK_P + b * 1088 + pos) * 128 + c8 * 8) = v;
    }
    u16* ki = (u16*)(p.wsp() + WS_KI);
    for (int i = gt; i < 2 * 8 * 1024 * 8; i += gs) {
      const int c8 = i & 7, pos = (i >> 3) & 1023, b = (i >> 13) & 7, e = i >> 16;
      const float* s = p.inp(I_CKI) + (size_t)i * 8;
      const float4 a = *(const float4*)s, bb = *(const float4*)(s + 4);
      uint4 v; v.x = pack2(a.x, a.y); v.y = pack2(a.z, a.w); v.z = pack2(bb.x, bb.y); v.w = pack2(bb.z, bb.w);
      *(uint4*)(ki + ((size_t)e * KROWS + NTOK_P + b * 1088 + pos) * 64 + c8 * 8) = v;
    }
    u16* vt = (u16*)(p.wsp() + WS_VT);
    for (int i = gt; i < 2 * 8 * 128 * 128; i += gs) {
      const int c = i & 127, p8 = (i >> 7) & 127, b = (i >> 14) & 7, e = i >> 17;
      const float* s = p.inp(I_CV) + (((size_t)e * 8 + b) * 1024 + p8 * 8) * 128 + c;
      uint4 v;
      v.x = pack2(s[0], s[128]); v.y = pack2(s[256], s[384]); v.z = pack2(s[512], s[640]); v.w = pack2(s[768], s[896]);
      *(uint4*)(vt + (size_t)e * KROWS * 128 + (size_t)NTOK_P * 128 + (size_t)b * 128 * 1088 + (size_t)c * 1088 + p8 * 8) = v;
    }
  }
}

DI void phase_norm(const PV& p, Blk B, int layer, bool final_, int tid) {
  const int lane = tid & 63, wave = tid >> 6;
  float* X = p.outp();
  u16* H = (u16*)(p.wsp() + WS_H);
  const float* gam = final_ ? p.inp(I_FINALG) : p.inp(I_NORMG) + layer * 1024;
  const float* modl = (const float*)(p.wsp() + WS_MOD) + (size_t)(final_ ? 0 : layer) * 24 * 3072;
  const int step = B.nb * 32;
  int tok0 = (B.bid * 8 + wave) * 4;
  float4 v[4][4], vn[4][4];
#define XROWS(dst, t0) do { _Pragma("unroll") for (int t = 0; t < 4; ++t) { \
      const int tok_ = (t0) + t; const float* xr_; \
      if (layer == 0 && !final_) xr_ = tok_ < NTOK_P ? p.inp(I_XP) + (size_t)tok_ * 1024 : p.inp(I_XS) + (size_t)(tok_ - NTOK_P) * 1024; \
      else xr_ = X + (size_t)tok_ * 1024; \
      _Pragma("unroll") for (int i = 0; i < 4; ++i) dst[t][i] = *(const float4*)(xr_ + i * 256 + lane * 4); } } while (0)
  if (tok0 < NTOK) XROWS(v, tok0);
  for (; tok0 < NTOK; tok0 += step) {
    float4 g4[4], sh[4], sc[4];
    const float* mr = modl + (size_t)mod_row(tok0) * 3072;
    const int tokn = tok0 + step;
    if (tokn < NTOK) XROWS(vn, tokn);
#pragma unroll
    for (int i = 0; i < 4; ++i) {
      const int c = i * 256 + lane * 4;
      g4[i] = *(const float4*)(gam + c);
      if (!final_) { sh[i] = *(const float4*)(mr + c); sc[i] = *(const float4*)(mr + 1024 + c); }
    }
    float ss[4] = {0.f, 0.f, 0.f, 0.f};
#pragma unroll
    for (int t = 0; t < 4; ++t) {
#pragma unroll
      for (int i = 0; i < 4; ++i) ss[t] += v[t][i].x * v[t][i].x + v[t][i].y * v[t][i].y + v[t][i].z * v[t][i].z + v[t][i].w * v[t][i].w;
    }
#pragma unroll
    for (int o = 32; o > 0; o >>= 1) {
#pragma unroll
      for (int t = 0; t < 4; ++t) ss[t] += __shfl_xor(ss[t], o);
    }
#pragma unroll
    for (int t = 0; t < 4; ++t) {
      const int tok = tok0 + t;
      const float rs = rsqrtf(ss[t] * (1.f / 1024.f) + 1e-6f);
#pragma unroll
      for (int i = 0; i < 4; ++i) {
        const int c = i * 256 + lane * 4;
        float4 y;
        y.x = v[t][i].x * rs * g4[i].x; y.y = v[t][i].y * rs * g4[i].y; y.z = v[t][i].z * rs * g4[i].z; y.w = v[t][i].w * rs * g4[i].w;
        if (final_) {
          *(float4*)(X + (size_t)tok * 1024 + c) = y;
        } else {
          uint2 o;
          o.x = pack2(y.x * (1.f + sc[i].x) + sh[i].x, y.y * (1.f + sc[i].y) + sh[i].y);
          o.y = pack2(y.z * (1.f + sc[i].z) + sh[i].z, y.w * (1.f + sc[i].w) + sh[i].w);
          *(uint2*)(H + (size_t)tok * 1024 + c) = o;
        }
      }
    }
#pragma unroll
    for (int t = 0; t < 4; ++t)
#pragma unroll
      for (int i = 0; i < 4; ++i) v[t][i] = vn[t][i];
  }
#undef XROWS
}

constexpr int LDB = 72;
constexpr int LDS2 = 136;
constexpr int CSB = 260;
constexpr int CSS = 132;
constexpr int CST = 132;

DI void gemm_big(const u16* __restrict__ A, const u16* __restrict__ Bt, int m0, int n0, unsigned char* lds, f32x16 (&acc)[4][2], int tid_in) {
  int tid = tid_in;
  asm volatile("" : "+v"(tid));
  constexpr int STAGE = 512 * LDB;
  u16* S0 = (u16*)lds;
  const int lane = tid & 63, wave = tid >> 6, wm = wave & 1, wn = wave >> 1;
  const int l31 = lane & 31, hi = lane >> 5;
  const int lrow = tid >> 3, lch = tid & 7;
  const u16* Ap = A + (size_t)(m0 + lrow) * 1024 + lch * 8;
  const u16* Bp = Bt + (size_t)(n0 + lrow) * 1024 + lch * 8;
  uint4 ra0, ra1, ra2, ra3, rb0, rb1, rb2, rb3;
#pragma unroll
  for (int i = 0; i < 4; ++i)
#pragma unroll
    for (int j = 0; j < 2; ++j)
#pragma unroll
      for (int r = 0; r < 16; ++r) acc[i][j][r] = 0.f;
#define GLOAD(k0) do { \
    ra0 = *(const uint4*)(Ap + (k0)); ra1 = *(const uint4*)(Ap + (size_t)64 * 1024 + (k0)); \
    ra2 = *(const uint4*)(Ap + (size_t)128 * 1024 + (k0)); ra3 = *(const uint4*)(Ap + (size_t)192 * 1024 + (k0)); \
    rb0 = *(const uint4*)(Bp + (k0)); rb1 = *(const uint4*)(Bp + (size_t)64 * 1024 + (k0)); \
    rb2 = *(const uint4*)(Bp + (size_t)128 * 1024 + (k0)); rb3 = *(const uint4*)(Bp + (size_t)192 * 1024 + (k0)); } while (0)
#define LWRITE(base) do { u16* aw_ = (base) + lrow * LDB + lch * 8; u16* bw_ = aw_ + 256 * LDB; \
    *(uint4*)(aw_) = ra0; *(uint4*)(aw_ + 64 * LDB) = ra1; *(uint4*)(aw_ + 128 * LDB) = ra2; *(uint4*)(aw_ + 192 * LDB) = ra3; \
    *(uint4*)(bw_) = rb0; *(uint4*)(bw_ + 64 * LDB) = rb1; *(uint4*)(bw_ + 128 * LDB) = rb2; *(uint4*)(bw_ + 192 * LDB) = rb3; } while (0)
#define COMPUTE(base, s) do { \
    const u16* ar_ = (base) + (wm * 128 + l31) * LDB + hi * 8 + (s) * 16; \
    const u16* br_ = (base) + 256 * LDB + (wn * 64 + l31) * LDB + hi * 8 + (s) * 16; \
    const bf16x8 b0 = *(const bf16x8*)(br_), b1 = *(const bf16x8*)(br_ + 32 * LDB); \
    _Pragma("unroll") for (int mi = 0; mi < 4; ++mi) { \
      const bf16x8 a = *(const bf16x8*)(ar_ + mi * 32 * LDB); \
      acc[mi][0] = MFMA32(a, b0, acc[mi][0]); acc[mi][1] = MFMA32(a, b1, acc[mi][1]); } } while (0)
  GLOAD(0);
  __syncthreads();
  LWRITE(S0);
  GLOAD(64);
  __syncthreads();
#pragma unroll 1
  for (int kt = 0; kt < 16; ++kt) {
    u16* cur = S0 + (kt & 1) * STAGE;
    u16* nxt = S0 + ((kt & 1) ^ 1) * STAGE;
    __builtin_amdgcn_s_setprio(1);
    COMPUTE(cur, 0);
    COMPUTE(cur, 1);
    __builtin_amdgcn_s_setprio(0);
    if (kt + 1 < 16) LWRITE(nxt);
    if (kt + 2 < 16) GLOAD((kt + 2) * 64);
    __builtin_amdgcn_s_setprio(1);
    COMPUTE(cur, 2);
    COMPUTE(cur, 3);
    __builtin_amdgcn_s_setprio(0);
    __syncthreads();
  }
#undef GLOAD
#undef LWRITE
#undef COMPUTE
}

DI void gemm_small(const u16* __restrict__ A, const u16* __restrict__ Bt, int m0, int n0, unsigned char* lds, f32x16 (&acc)[2], int tid_in) {
  int tid = tid_in;
  asm volatile("" : "+v"(tid));
  constexpr int STAGE = 320 * LDB;
  u16* S0 = (u16*)lds;
  const int lane = tid & 63, wave = tid >> 6, wm = wave & 1, wn = wave >> 1;
  const int l31 = lane & 31, hi = lane >> 5;
  const int lrow = tid >> 3, lch = tid & 7;
  const u16* Ap = A + (size_t)(m0 + lrow) * 1024 + lch * 8;
  const u16* Bp = Bt + (size_t)(n0 + lrow) * 1024 + lch * 8;
  uint4 ra0, rb0, rb1, rb2, rb3;
#pragma unroll
  for (int r = 0; r < 16; ++r) { acc[0][r] = 0.f; acc[1][r] = 0.f; }
#define GLOAD(k0) do { \
    ra0 = *(const uint4*)(Ap + (k0)); \
    rb0 = *(const uint4*)(Bp + (k0)); rb1 = *(const uint4*)(Bp + (size_t)64 * 1024 + (k0)); \
    rb2 = *(const uint4*)(Bp + (size_t)128 * 1024 + (k0)); rb3 = *(const uint4*)(Bp + (size_t)192 * 1024 + (k0)); } while (0)
#define LWRITE(base) do { u16* aw_ = (base) + lrow * LDB + lch * 8; u16* bw_ = aw_ + 64 * LDB; \
    *(uint4*)(aw_) = ra0; \
    *(uint4*)(bw_) = rb0; *(uint4*)(bw_ + 64 * LDB) = rb1; *(uint4*)(bw_ + 128 * LDB) = rb2; *(uint4*)(bw_ + 192 * LDB) = rb3; } while (0)
#define COMPUTE(base, s) do { \
    const u16* ar_ = (base) + (wm * 32 + l31) * LDB + hi * 8 + (s) * 16; \
    const u16* br_ = (base) + 64 * LDB + (wn * 64 + l31) * LDB + hi * 8 + (s) * 16; \
    const bf16x8 a = *(const bf16x8*)(ar_), b0 = *(const bf16x8*)(br_), b1 = *(const bf16x8*)(br_ + 32 * LDB); \
    acc[0] = MFMA32(a, b0, acc[0]); acc[1] = MFMA32(a, b1, acc[1]); } while (0)
  GLOAD(0);
  __syncthreads();
  LWRITE(S0);
  GLOAD(64);
  __syncthreads();
#pragma unroll 1
  for (int kt = 0; kt < 16; ++kt) {
    u16* cur = S0 + (kt & 1) * STAGE;
    u16* nxt = S0 + ((kt & 1) ^ 1) * STAGE;
    COMPUTE(cur, 0);
    COMPUTE(cur, 1);
    if (kt + 1 < 16) LWRITE(nxt);
    if (kt + 2 < 16) GLOAD((kt + 2) * 64);
    COMPUTE(cur, 2);
    COMPUTE(cur, 3);
    __syncthreads();
  }
#undef GLOAD
#undef LWRITE
#undef COMPUTE
}

DI void stage_big(const f32x16 (&a)[2], float* Cs, int tid) {
  const int lane = tid & 63, wave = tid >> 6, wm = wave & 1, wn = wave >> 1, l31 = lane & 31, hi = lane >> 5;
#pragma unroll
  for (int ni = 0; ni < 2; ++ni)
#pragma unroll
    for (int r = 0; r < 16; ++r)
      Cs[(wm * 32 + (r & 3) + 8 * (r >> 2) + 4 * hi) * CSB + wn * 64 + ni * 32 + l31] = a[ni][r];
}
DI void stage_small(const f32x16& a, float* Cs, int tid) {
  const int lane = tid & 63, wave = tid >> 6, wm = wave & 1, wn = wave >> 1, l31 = lane & 31, hi = lane >> 5;
#pragma unroll
  for (int r = 0; r < 16; ++r)
    Cs[(wm * 32 + (r & 3) + 8 * (r >> 2) + 4 * hi) * CSS + wn * 32 + l31] = a[r];
}
struct Slab { const float* Cs; int cst; int m0, rstride, roff; };
DI int slab_tok(const Slab& S, int row) { return S.m0 + (row >> 5) * S.rstride + S.roff + (row & 31); }

DI bool big_tile_coords(int bid, int nb, int round, int NTb, int& mt, int& nt) {
  if (nb != 256) {
    const int t = bid + round * nb;
    if (t >= 128 * NTb) return false;
    mt = t / NTb; nt = t % NTb;
    return true;
  }
  const int x = bid & 7, q = (bid >> 3) + 32 * round;
  if (q >= 16 * NTb) return false;
  const int grp = q / (4 * NTb), qq = q - grp * 4 * NTb;
  const int c = qq >> 5, r = qq & 31;
  const int w = min(8, NTb - c * 8);
  mt = x * 16 + grp * 4 + r / w; nt = c * 8 + r % w;
  return true;
}

struct EvenOut { u16* P; u16* KB; u16* VT; u16* KI; float* WI; float* out; int e; };
DI void epi_even(const Slab& S, int t, const EvenOut& E, int tid) {
  const bool smp = S.m0 >= NTOK_P;
  const int e = E.e;
  if (t == 2) {
#pragma unroll 2
    for (int i = 0; i < 4; ++i) {
      const int idx = tid + NTHREADS * i, row = idx >> 5, c = (idx & 31) * 4;
      const int tok = slab_tok(S, row);
      const float4 kq = *(const float4*)(S.Cs + row * S.cst + c), vq = *(const float4*)(S.Cs + row * S.cst + 128 + c);
      const size_t ok = !smp ? O_KP + ((size_t)e * NTOK_P + tok) * 128 + c : O_KS + ((size_t)e * NTOK_S + (tok - NTOK_P)) * 128 + c;
      const size_t ov = !smp ? O_VP + ((size_t)e * NTOK_P + tok) * 128 + c : O_VS + ((size_t)e * NTOK_S + (tok - NTOK_P)) * 128 + c;
      *(float4*)(E.out + ok) = kq;
      *(float4*)(E.out + ov) = vq;
      uint2 pk; pk.x = pack2(kq.x, kq.y); pk.y = pack2(kq.z, kq.w);
      *(uint2*)(E.KB + (size_t)key_row(tok) * 128 + c) = pk;
    }
#pragma unroll
    for (int i = 0; i < 2; ++i) {
      const int idx = tid + NTHREADS * i, c = idx & 127, rg = idx >> 7;
      const int tok = slab_tok(S, rg * 8);
      const float* cp = S.Cs + (rg * 8) * S.cst + 128 + c;
      const int cs = S.cst;
      uint4 pk;
      pk.x = pack2(cp[0], cp[cs]); pk.y = pack2(cp[2 * cs], cp[3 * cs]); pk.z = pack2(cp[4 * cs], cp[5 * cs]); pk.w = pack2(cp[6 * cs], cp[7 * cs]);
      size_t vo;
      if (!smp) vo = (size_t)(tok >> 11) * 128 * 2048 + (size_t)c * 2048 + (tok & 2047);
      else vo = (size_t)NTOK_P * 128 + (size_t)((tok - NTOK_P) >> 6) * 128 * 1088 + (size_t)c * 1088 + 1024 + ((tok - NTOK_P) & 63);
      *(uint4*)(E.VT + vo) = pk;
    }
  } else if (t == 7) {
#pragma unroll 2
    for (int i = 0; i < 4; ++i) {
      const int idx = tid + NTHREADS * i, row = idx >> 5, c = (idx & 31) * 4;
      const int tok = slab_tok(S, row);
      const float4 v = *(const float4*)(S.Cs + row * S.cst + c);
      if (c < 64) {
        const size_t oo = !smp ? O_KIP + ((size_t)e * NTOK_P + tok) * 64 + c : O_KIS + ((size_t)e * NTOK_S + (tok - NTOK_P)) * 64 + c;
        *(float4*)(E.out + oo) = v;
        uint2 pk; pk.x = pack2(v.x, v.y); pk.y = pack2(v.z, v.w);
        *(uint2*)(E.KI + (size_t)key_row(tok) * 64 + c) = pk;
      } else if (c < 72) {
        *(float4*)(E.WI + (size_t)tok * 8 + (c - 64)) = v;
      }
    }
  } else if (t >= 8) {
    const bool isz = t < 12;
    const int pc = isz ? C_Z + (t - 8) * 128 : C_GBZ + (t - 12) * 128;
#pragma unroll 2
    for (int i = 0; i < 4; ++i) {
      const int idx = tid + NTHREADS * i, row = idx >> 5, c = (idx & 31) * 4;
      const int tok = slab_tok(S, row);
      const float4 a = *(const float4*)(S.Cs + row * S.cst + c), b2 = *(const float4*)(S.Cs + row * S.cst + 128 + c);
      float4 r;
      if (isz) { r.x = a.x * b2.x; r.y = a.y * b2.y; r.z = a.z * b2.z; r.w = a.w * b2.w; }
      else { r.x = a.x * silu_f(b2.x); r.y = a.y * silu_f(b2.y); r.z = a.z * silu_f(b2.z); r.w = a.w * silu_f(b2.w); }
      uint2 pk; pk.x = pack2(r.x, r.y); pk.y = pack2(r.z, r.w);
      *(uint2*)(E.P + (size_t)tok * PSE + pc + c) = pk;
      if (isz) {
        const int pos = smp ? (tok - NTOK_P) & 63 : tok & 2047;
        const int last = smp ? 62 : 2046;
        if (pos >= last) {
          float* o = smp ? E.out + O_CVS + (((size_t)e * 8 + ((tok - NTOK_P) >> 6)) * 2 + (pos - last)) * 512
                         : E.out + O_CVP + (((size_t)e * 16 + (tok >> 11)) * 2 + (pos - last)) * 512;
          *(float4*)(o + (t - 8) * 128 + c) = r;
        }
      }
    }
  } else {
    const int pc = t < 2 ? C_Q + t * 256 : (t < 5 ? C_GA + (t - 3) * 256 : C_QI + (t - 5) * 256);
#pragma unroll 2
    for (int i = 0; i < 4; ++i) {
      const int idx = tid + NTHREADS * i, row = idx >> 5, c = (idx & 31) * 4;
      const int tok = slab_tok(S, row);
      float4 a = *(const float4*)(S.Cs + row * S.cst + c), b2 = *(const float4*)(S.Cs + row * S.cst + 128 + c);
      if (t < 2) {
        const float qs = 0.18033688011112042f;
        a.x *= qs; a.y *= qs; a.z *= qs; a.w *= qs; b2.x *= qs; b2.y *= qs; b2.z *= qs; b2.w *= qs;
      } else if (t < 5) {
        a.x = silu_f(a.x); a.y = silu_f(a.y); a.z = silu_f(a.z); a.w = silu_f(a.w);
        b2.x = silu_f(b2.x); b2.y = silu_f(b2.y); b2.z = silu_f(b2.z); b2.w = silu_f(b2.w);
      }
      uint2 pa, pb; pa.x = pack2(a.x, a.y); pa.y = pack2(a.z, a.w); pb.x = pack2(b2.x, b2.y); pb.y = pack2(b2.z, b2.w);
      *(uint2*)(E.P + (size_t)tok * PSE + pc + c) = pa;
      *(uint2*)(E.P + (size_t)tok * PSE + pc + 128 + c) = pb;
    }
  }
}

DI void phase_gemm_even_in(const PV& p, Blk B, int e, unsigned char* lds, int tid) {
  const u16* H = (const u16*)(p.wsp() + WS_H);
  const u16* W = (const u16*)(p.wsp() + WS_WEIN) + (size_t)e * WE_ROWS * 1024;
  EvenOut E;
  E.P = (u16*)(p.wsp() + WS_P);
  E.KB = (u16*)(p.wsp() + WS_KB) + (size_t)e * KROWS * 128;
  E.VT = (u16*)(p.wsp() + WS_VT) + (size_t)e * KROWS * 128;
  E.KI = (u16*)(p.wsp() + WS_KI) + (size_t)e * KROWS * 64;
  E.WI = (float*)(p.wsp() + WS_WI);
  E.out = p.outp(); E.e = e;
  float* Cs = (float*)lds;
  for (int round = 0;; ++round) {
    int mt, nt;
    if (!big_tile_coords(B.bid, B.nb, round, 16, mt, nt)) break;
    f32x16 acc[4][2];
    gemm_big(H, W, mt * 256, nt * 256, lds, acc, tid);
#pragma unroll
    for (int mi = 0; mi < 4; ++mi) {
      float* Cb = Cs + (mi & 1) * (64 * CSB);
      stage_big(acc[mi], Cb, tid);
      __syncthreads();
      Slab S; S.Cs = Cb; S.cst = CSB; S.m0 = mt * 256; S.rstride = 128; S.roff = mi * 32;
      epi_even(S, nt, E, tid);
    }
  }
  for (int t = B.bid; t < 8 * 16; t += B.nb) {
    const int ms = t >> 4, nt = t & 15;
    f32x16 acc[2];
    gemm_small(H, W, NTOK_P + ms * 64, nt * 256, lds, acc, tid);
    stage_big(acc, Cs, tid);
    __syncthreads();
    Slab S; S.Cs = Cs; S.cst = CSB; S.m0 = NTOK_P + ms * 64; S.rstride = 32; S.roff = 0;
    epi_even(S, nt, E, tid);
    __syncthreads();
  }
}

DI void epi_odd(const Slab& S, int t, u16* P, int tid) {
#pragma unroll 2
  for (int i = 0; i < 4; ++i) {
    const int idx = tid + NTHREADS * i, row = idx >> 5, c = (idx & 31) * 4;
    const int tok = slab_tok(S, row);
    const float4 a = *(const float4*)(S.Cs + row * S.cst + c), b2 = *(const float4*)(S.Cs + row * S.cst + 128 + c);
    if (t < 8) {
      float4 r;
      r.x = gelu_f(a.x) * silu_f(b2.x); r.y = gelu_f(a.y) * silu_f(b2.y); r.z = gelu_f(a.z) * silu_f(b2.z); r.w = gelu_f(a.w) * silu_f(b2.w);
      uint2 pk; pk.x = pack2(r.x, r.y); pk.y = pack2(r.z, r.w);
      *(uint2*)(P + (size_t)tok * PSO + t * 128 + c) = pk;
    } else {
      uint2 pa, pb;
      pa.x = pack2(gelu_f(a.x), gelu_f(a.y)); pa.y = pack2(gelu_f(a.z), gelu_f(a.w));
      pb.x = pack2(gelu_f(b2.x), gelu_f(b2.y)); pb.y = pack2(gelu_f(b2.z), gelu_f(b2.w));
      *(uint2*)(P + (size_t)tok * PSO + 1024 + (t - 8) * 256 + c) = pa;
      *(uint2*)(P + (size_t)tok * PSO + 1024 + (t - 8) * 256 + 128 + c) = pb;
    }
  }
}
DI void phase_gemm_odd_in(const PV& p, Blk B, int o, unsigned char* lds, int tid) {
  const u16* H = (const u16*)(p.wsp() + WS_H);
  const u16* W = (const u16*)(p.wsp() + WS_WOIN) + (size_t)o * WO_ROWS * 1024;
  u16* P = (u16*)(p.wsp() + WS_P);
  float* Cs = (float*)lds;
  for (int round = 0;; ++round) {
    int mt, nt;
    if (!big_tile_coords(B.bid, B.nb, round, 12, mt, nt)) break;
    f32x16 acc[4][2];
    gemm_big(H, W, mt * 256, nt * 256, lds, acc, tid);
#pragma unroll
    for (int mi = 0; mi < 4; ++mi) {
      float* Cb = Cs + (mi & 1) * (64 * CSB);
      stage_big(acc[mi], Cb, tid);
      __syncthreads();
      Slab S; S.Cs = Cb; S.cst = CSB; S.m0 = mt * 256; S.rstride = 128; S.roff = mi * 32;
      epi_odd(S, nt, P, tid);
    }
  }
  for (int t = B.bid; t < 8 * 12; t += B.nb) {
    const int ms = t / 12, nt = t - ms * 12;
    f32x16 acc[2];
    gemm_small(H, W, NTOK_P + ms * 64, nt * 256, lds, acc, tid);
    stage_big(acc, Cs, tid);
    __syncthreads();
    Slab S; S.Cs = Cs; S.cst = CSB; S.m0 = NTOK_P + ms * 64; S.rstride = 32; S.roff = 0;
    epi_odd(S, nt, P, tid);
    __syncthreads();
  }
}

struct OutArgs { const float* modl; const float* xp; const float* xs; float* X; int layer; };
DI void epi_out(const Slab& S, int coff, int n0s, const OutArgs& O, int tid_in) {
  int tid = tid_in;
  asm volatile("" : "+v"(tid));
  float4 xv[4], gv[4];
#pragma unroll
  for (int i = 0; i < 4; ++i) {
    const int idx = tid + NTHREADS * i, row = idx >> 5, c = (idx & 31) * 4;
    const int tok = slab_tok(S, row);
    const float* xr = O.layer == 0 ? (tok < NTOK_P ? O.xp + (size_t)tok * 1024 : O.xs + (size_t)(tok - NTOK_P) * 1024) : O.X + (size_t)tok * 1024;
    xv[i] = *(const float4*)(xr + n0s + c);
    gv[i] = *(const float4*)(O.modl + (size_t)mod_row(tok) * 3072 + 2048 + n0s + c);
  }
#pragma unroll
  for (int i = 0; i < 4; ++i) {
    const int idx = tid + NTHREADS * i, row = idx >> 5, c = (idx & 31) * 4;
    const int tok = slab_tok(S, row);
    const float4 v = *(const float4*)(S.Cs + row * S.cst + coff + c);
    float4 x = xv[i];
    x.x += gv[i].x * v.x; x.y += gv[i].y * v.y; x.z += gv[i].z * v.z; x.w += gv[i].w * v.w;
    *(float4*)(O.X + (size_t)tok * 1024 + n0s + c) = x;
  }
}
DI void phase_gemm_out(const PV& p, Blk B, int layer, unsigned char* lds, int tid) {
  const u16* A = (const u16*)(p.wsp() + WS_H);
  const u16* W = (layer & 1) ? (const u16*)(p.wsp() + WS_WOOUT) + (size_t)(layer >> 1) * 1024 * 1024
                             : (const u16*)(p.wsp() + WS_WEOUT) + (size_t)(layer >> 1) * 1024 * 1024;
  OutArgs O;
  O.modl = (const float*)(p.wsp() + WS_MOD) + (size_t)layer * 24 * 3072;
  O.xp = p.inp(I_XP); O.xs = p.inp(I_XS); O.X = p.outp(); O.layer = layer;
  float* Cs = (float*)lds;
  for (int round = 0;; ++round) {
    int mt, nt;
    if (!big_tile_coords(B.bid, B.nb, round, 4, mt, nt)) break;
    f32x16 acc[4][2];
    gemm_big(A, W, mt * 256, nt * 256, lds, acc, tid);
    {
      int tid_e = tid;
      asm volatile("" : "+v"(tid_e));
      const int c = (tid_e & 31) * 4, r0 = tid_e >> 5;
      const float* xsrc = layer == 0 ? p.inp(I_XP) : O.X;
      const float* grow = O.modl + (size_t)mod_row(mt * 256) * 3072 + 2048 + nt * 256 + c;
      const float4 g0 = *(const float4*)grow, g1 = *(const float4*)(grow + 128);
#pragma unroll
      for (int mi = 0; mi < 4; ++mi) {
        float* Cb = Cs + (mi & 1) * (64 * CSB);
        float4 xv[4][2];
#pragma unroll
        for (int i = 0; i < 4; ++i) {
          const int row = r0 + 16 * i;
          const size_t off = (size_t)(mt * 256 + (row >> 5) * 128 + mi * 32 + (row & 31)) * 1024 + nt * 256 + c;
          xv[i][0] = *(const float4*)(xsrc + off); xv[i][1] = *(const float4*)(xsrc + off + 128);
        }
        stage_big(acc[mi], Cb, tid);
        __syncthreads();
#pragma unroll
        for (int i = 0; i < 4; ++i) {
          const int row = r0 + 16 * i;
          const size_t off = (size_t)(mt * 256 + (row >> 5) * 128 + mi * 32 + (row & 31)) * 1024 + nt * 256 + c;
          const float4 v0 = *(const float4*)(Cb + row * CSB + c), v1 = *(const float4*)(Cb + row * CSB + 128 + c);
          float4 x0 = xv[i][0], x1 = xv[i][1];
          x0.x += g0.x * v0.x; x0.y += g0.y * v0.y; x0.z += g0.z * v0.z; x0.w += g0.w * v0.w;
          x1.x += g1.x * v1.x; x1.y += g1.y * v1.y; x1.z += g1.z * v1.z; x1.w += g1.w * v1.w;
          *(float4*)(O.X + off) = x0; *(float4*)(O.X + off + 128) = x1;
        }
      }
    }
  }
  for (int t = B.bid; t < 8 * 4; t += B.nb) {
    const int ms = t >> 2, nt = t & 3;
    f32x16 acc[2];
    gemm_small(A, W, NTOK_P + ms * 64, nt * 256, lds, acc, tid);
    stage_big(acc, Cs, tid);
    __syncthreads();
    Slab S; S.Cs = Cs; S.cst = CSB; S.m0 = NTOK_P + ms * 64; S.rstride = 32; S.roff = 0;
    epi_out(S, 0, nt * 256, O, tid);
    epi_out(S, 128, nt * 256 + 128, O, tid);
    __syncthreads();
  }
}

constexpr int MSTR = 33;
template <int NREG>
DI void select_top256(unsigned (&raw)[NREG], const u16* __restrict__ nsrow, u64* __restrict__ mrow, int nkt, int lane) {
  unsigned kv[NREG];
#pragma unroll
  for (int i = 0; i < NREG; ++i) {
    const unsigned u = raw[i];
    kv[i] = i < nkt ? ((u & 0x8000u) ? (~u & 0xffffu) : (u | 0x8000u)) : 0u;
  }
#pragma unroll
  for (int i = 0; i < NREG; ++i) if (i < nkt) raw[i] = nsrow[i * 64 + lane];
  unsigned T = 0;
  for (int bit = 15; bit >= 0; --bit) {
    const unsigned cand = T | (1u << bit);
    int cnt = 0;
#pragma unroll
    for (int i = 0; i < NREG; ++i) cnt += __popcll(__ballot(kv[i] >= cand));
    if (cnt >= 256) T = cand;
  }
  int cgt = 0;
#pragma unroll
  for (int i = 0; i < NREG; ++i) cgt += __popcll(__ballot(kv[i] > T));
  const int need = 256 - cgt;
  int run = 0;
  const u64 below = (1ull << lane) - 1ull;
  unsigned T2 = __builtin_amdgcn_readfirstlane(T);
  asm volatile("" : "+s"(T2));
#pragma unroll
  for (int i = 0; i < NREG; ++i) {
    if (i < nkt) {
      const u64 eq = __ballot(kv[i] == T2), gtm = __ballot(kv[i] > T2);
      const int pre = __popcll(eq & below);
      const bool se = (kv[i] == T2) && (run + pre < need);
      const u64 sel = gtm | __ballot(se);
      run += __popcll(eq);
      if (lane == 0) mrow[i] = sel;
    }
  }
}
template <int NREG>
DI void select_item(const u16* __restrict__ SC, u64* __restrict__ MASK, int wave, int nkt, int lane) {
  unsigned raw[NREG];
  const u16* s0 = SC + (size_t)(wave * 8) * 2048;
#pragma unroll
  for (int i = 0; i < NREG; ++i) raw[i] = i < nkt ? (unsigned)s0[i * 64 + lane] : 0u;
#pragma unroll 1
  for (int qi = 0; qi < 8; ++qi) {
    const int q = wave * 8 + qi;
    const int qn = qi < 7 ? q + 1 : q;
    select_top256<NREG>(raw, SC + (size_t)qn * 2048, MASK + q * MSTR, nkt, lane);
  }
}

constexpr int KSTR = 136;
constexpr int VTSTR = 68;
DI void phase_attn(const PV& p, Blk B, int e, unsigned char* lds, int tid) {
  const int lane = tid & 63, wave = tid >> 6, l31 = lane & 31, hi = lane >> 5;
  const u16* P = (const u16*)(p.wsp() + WS_P);
  const u16* KBe = (const u16*)(p.wsp() + WS_KB) + (size_t)e * KROWS * 128;
  const u16* VTe = (const u16*)(p.wsp() + WS_VT) + (size_t)e * KROWS * 128;
  const u16* KIe = (const u16*)(p.wsp() + WS_KI) + (size_t)e * KROWS * 64;
  const float* WI = (const float*)(p.wsp() + WS_WI);
  u16* AB = (u16*)(p.wsp() + WS_H);
  u16* SC = (u16*)(p.wsp() + WS_SC) + (size_t)B.bid * 64 * 2048;
  u64* MASK = (u64*)lds;
  float* out = p.outp();
  constexpr int NITEMS = 520;
  unsigned* qctr = (unsigned*)(p.wsp() + WS_CTR) + e;
  int* itw = (int*)(lds + LDS_BYTES - 16);
  for (;;) {
    __syncthreads();
    if (tid == 0) *itw = (int)atomicAdd(qctr, 1u);
    __syncthreads();
    const int it = *itw;
    if (it >= NITEMS) break;
    int seq, tok0, nkt, Lseq; size_t kbase, vbase;
    bool is_s;
    if (it >= 240 && it < 248) {
      const int si = it - 240;
      is_s = true; seq = 16 + si; tok0 = NTOK_P + si * 64; nkt = 17; Lseq = 1088;
      kbase = (size_t)NTOK_P + (size_t)si * 1088; vbase = (size_t)NTOK_P * 128 + (size_t)si * 128 * 1088;
    } else {
      is_s = false; const int k = it < 240 ? it : it - 8; const int c = 31 - (k >> 4); seq = k & 15; tok0 = seq * 2048 + c * 64; nkt = c + 1; Lseq = 2048;
      kbase = (size_t)seq * 2048; vbase = (size_t)seq * 128 * 2048;
    }
    const int Nk = nkt * 64;

    for (int rep_ = 0; rep_ < ((ATT_REP & 8) ? 2 : 1); ++rep_) {
      const int c = lane * 8;
      const float* cw = p.inp(I_EVCONV) + (size_t)e * 3 * 512 + c;
      float w0[8], w1[8], w2[8], z1[8] = {0.f, 0.f, 0.f, 0.f, 0.f, 0.f, 0.f, 0.f}, z2[8] = {0.f, 0.f, 0.f, 0.f, 0.f, 0.f, 0.f, 0.f};
      {
        const float4 a0 = *(const float4*)cw, a1 = *(const float4*)(cw + 4), b0 = *(const float4*)(cw + 512), b1 = *(const float4*)(cw + 516),
                     c0 = *(const float4*)(cw + 1024), c1 = *(const float4*)(cw + 1028);
        w0[0] = a0.x; w0[1] = a0.y; w0[2] = a0.z; w0[3] = a0.w; w0[4] = a1.x; w0[5] = a1.y; w0[6] = a1.z; w0[7] = a1.w;
        w1[0] = b0.x; w1[1] = b0.y; w1[2] = b0.z; w1[3] = b0.w; w1[4] = b1.x; w1[5] = b1.y; w1[6] = b1.z; w1[7] = b1.w;
        w2[0] = c0.x; w2[1] = c0.y; w2[2] = c0.z; w2[3] = c0.w; w2[4] = c1.x; w2[5] = c1.y; w2[6] = c1.z; w2[7] = c1.w;
      }
      const int tl0 = wave * 8;
      uint4 zq[10], gq[8];
      const bool halo_mem = tl0 > 0 || (!is_s && (tok0 & 2047) != 0);
#pragma unroll
      for (int r = 0; r < 10; ++r) {
        const int tl = tl0 + r - 2;
        const int tls = (r < 2 && !halo_mem) ? 0 : tl;
        zq[r] = *(const uint4*)(P + (size_t)(tok0 + tls) * PSE + C_Z + c);
      }
#pragma unroll
      for (int r = 0; r < 8; ++r) gq[r] = *(const uint4*)(P + (size_t)(tok0 + tl0 + r) * PSE + C_GBZ + c);
      float4 h0a = make_float4(0.f, 0.f, 0.f, 0.f), h0b = h0a, h1a = h0a, h1b = h0a;
      if (!halo_mem && is_s) {
        const float* hs = p.inp(I_SCONV) + ((size_t)e * 8 + (seq - 16)) * 2 * 512 + c;
        h0a = *(const float4*)hs; h0b = *(const float4*)(hs + 4); h1a = *(const float4*)(hs + 512); h1b = *(const float4*)(hs + 516);
      }
#pragma unroll
      for (int r = 0; r < 10; ++r) {
        float z[8];
        if (r < 2 && !halo_mem) {
          const float4 a = r == 0 ? h0a : h1a, b2 = r == 0 ? h0b : h1b;
          z[0] = a.x; z[1] = a.y; z[2] = a.z; z[3] = a.w; z[4] = b2.x; z[5] = b2.y; z[6] = b2.z; z[7] = b2.w;
        } else {
          const unsigned zw[4] = {zq[r].x, zq[r].y, zq[r].z, zq[r].w};
#pragma unroll
          for (int i = 0; i < 4; ++i) { z[2 * i] = bf2f((u16)(zw[i] & 0xffff)); z[2 * i + 1] = bf2f((u16)(zw[i] >> 16)); }
        }
        if (r >= 2) {
          const unsigned bw[4] = {gq[r - 2].x, gq[r - 2].y, gq[r - 2].z, gq[r - 2].w};
          float y[8];
#pragma unroll
          for (int i = 0; i < 8; ++i) y[i] = w2[i] * z[i] + w1[i] * z1[i] + w0[i] * z2[i];
          unsigned ow[4];
#pragma unroll
          for (int i = 0; i < 4; ++i) ow[i] = pack2(bf2f((u16)(bw[i] & 0xffff)) * y[2 * i], bf2f((u16)(bw[i] >> 16)) * y[2 * i + 1]);
          uint4 ov; ov.x = ow[0]; ov.y = ow[1]; ov.z = ow[2]; ov.w = ow[3];
          *(uint4*)(AB + (size_t)(tok0 + tl0 + r - 2) * 1024 + 512 + c) = ov;
        }
#pragma unroll
        for (int i = 0; i < 8; ++i) { z2[i] = z1[i]; z1[i] = z[i]; }
      }
    }

    for (int rep_ = 0; rep_ < ((ATT_REP & 1) ? 2 : 1); ++rep_)
    if (Nk > 256) {
      const int qb = wave & 3, kp = wave >> 2;
      int lane_a = lane;
      asm volatile("" : "+v"(lane_a));
      const int l15 = lane_a & 15, l4 = lane_a >> 4;
      const int qtok = tok0 + qb * 16 + l15;
      bf16x8 bq[8][2];
      float wi[8];
#pragma unroll
      for (int h = 0; h < 8; ++h) {
        bq[h][0] = *(const bf16x8*)(P + (size_t)qtok * PSE + C_QI + h * 64 + l4 * 8);
        bq[h][1] = *(const bf16x8*)(P + (size_t)qtok * PSE + C_QI + h * 64 + 32 + l4 * 8);
        wi[h] = WI[(size_t)qtok * 8 + h];
      }
      const int ntl = (nkt - kp + 1) >> 1;
      const u16* kr0 = KIe + (kbase + l15) * 64 + l4 * 8;
      bf16x8 ca[4][2];
#pragma unroll
      for (int kb = 0; kb < 4; ++kb) {
        ca[kb][0] = *(const bf16x8*)(kr0 + (size_t)(kp * 64 + kb * 16) * 64);
        ca[kb][1] = *(const bf16x8*)(kr0 + (size_t)(kp * 64 + kb * 16) * 64 + 32);
      }
#pragma unroll 1
      for (int tl = 0; tl < ntl; ++tl) {
        const int kt = kp + 2 * tl;
        const int ktn = tl + 1 < ntl ? kt + 2 : kt;
#pragma unroll
        for (int kb = 0; kb < 4; ++kb) {
          float s0 = 0.f, s1 = 0.f, s2 = 0.f, s3 = 0.f;
#pragma unroll
          for (int h = 0; h < 8; ++h) {
            f32x4 c = {0.f, 0.f, 0.f, 0.f};
            c = MFMA16(ca[kb][0], bq[h][0], c);
            c = MFMA16(ca[kb][1], bq[h][1], c);
            s0 += wi[h] * fmaxf(c[0], 0.f); s1 += wi[h] * fmaxf(c[1], 0.f);
            s2 += wi[h] * fmaxf(c[2], 0.f); s3 += wi[h] * fmaxf(c[3], 0.f);
          }
          ca[kb][0] = *(const bf16x8*)(kr0 + (size_t)(ktn * 64 + kb * 16) * 64);
          ca[kb][1] = *(const bf16x8*)(kr0 + (size_t)(ktn * 64 + kb * 16) * 64 + 32);
          const _Float16 h0 = (_Float16)s0, h1 = (_Float16)s1, h2 = (_Float16)s2, h3 = (_Float16)s3;
          uint2 pk;
          pk.x = (unsigned)__builtin_bit_cast(u16, h0) | ((unsigned)__builtin_bit_cast(u16, h1) << 16);
          pk.y = (unsigned)__builtin_bit_cast(u16, h2) | ((unsigned)__builtin_bit_cast(u16, h3) << 16);
          *(uint2*)(SC + (size_t)(qb * 16 + l15) * 2048 + kt * 64 + kb * 16 + l4 * 4) = pk;
          __builtin_amdgcn_sched_barrier(0);
        }
      }
    }
    __syncthreads();

    for (int rep_ = 0; rep_ < ((ATT_REP & 2) ? 2 : 1); ++rep_) {
      if (Nk <= 256) {
        for (int qi = 0; qi < 8; ++qi) if (lane < nkt) MASK[(wave * 8 + qi) * MSTR + lane] = ~0ull;
      } else if (nkt <= 8) select_item<8>(SC, MASK, wave, nkt, lane);
      else if (nkt <= 16) select_item<16>(SC, MASK, wave, nkt, lane);
      else if (nkt <= 24) select_item<24>(SC, MASK, wave, nkt, lane);
      else select_item<32>(SC, MASK, wave, nkt, lane);
    }
    __syncthreads();

    for (int rep_ = 0; rep_ < ((ATT_REP & 4) ? 2 : 1); ++rep_) {
      int tid_c = tid;
      asm volatile("" : "+v"(tid_c));
      const int l31 = tid_c & 31, hi = (tid_c >> 5) & 1;
      const int qh = wave & 1, hp = wave >> 1, g = hp >> 1;
      const int qtok = tok0 + qh * 32 + l31;
      u16* Ks = (u16*)(lds + 64 * MSTR * 8);
      u16* Vs = Ks + 64 * KSTR;
      const int kr_ = tid_c >> 4, kc_ = (tid_c & 15) * 8;
      const int vr_ = tid_c >> 3, vc_ = (tid_c & 7) * 8;
      const u16* kg = KBe + (kbase + kr_) * 128 + kc_;
      const u16* vg = VTe + vbase + (size_t)vr_ * Lseq + vc_;
      const unsigned* mq = (const unsigned*)(MASK + (qh * 32 + l31) * MSTR);
      const u16* ksr = Ks + l31 * KSTR + g * 64 + hi * 8;
      const u16* vsr = Vs + (g * 64 + l31) * VTSTR + hi * 4;
      uint4 ak0 = *(const uint4*)kg, ak1 = *(const uint4*)(kg + 32 * 128);
      uint4 av0 = *(const uint4*)vg, av1 = *(const uint4*)(vg + (size_t)64 * Lseq);
      bf16x8 qf[2][4];
#pragma unroll
      for (int j = 0; j < 2; ++j)
#pragma unroll
        for (int s = 0; s < 4; ++s) qf[j][s] = *(const bf16x8*)(P + (size_t)qtok * PSE + C_Q + (hp * 2 + j) * 64 + s * 16 + hi * 8);
      f32x16 o[2][2];
#pragma unroll
      for (int j = 0; j < 2; ++j)
#pragma unroll
        for (int db = 0; db < 2; ++db)
#pragma unroll
          for (int r = 0; r < 16; ++r) o[j][db][r] = 0.f;
      float l_[2] = {0.f, 0.f};
#pragma unroll 1
      for (int kt = 0; kt < nkt; ++kt) {
        __syncthreads();
        *(uint4*)(Ks + kr_ * KSTR + kc_) = ak0; *(uint4*)(Ks + (kr_ + 32) * KSTR + kc_) = ak1;
        *(uint2*)(Vs + vr_ * VTSTR + vc_) = make_uint2(av0.x, av0.y); *(uint2*)(Vs + vr_ * VTSTR + vc_ + 4) = make_uint2(av0.z, av0.w);
        *(uint2*)(Vs + (vr_ + 64) * VTSTR + vc_) = make_uint2(av1.x, av1.y); *(uint2*)(Vs + (vr_ + 64) * VTSTR + vc_ + 4) = make_uint2(av1.z, av1.w);
        __syncthreads();
        if (kt + 1 < nkt) {
          const u16* kg2 = kg + (size_t)(kt + 1) * 64 * 128;
          const u16* vg2 = vg + (kt + 1) * 64;
          ak0 = *(const uint4*)kg2; ak1 = *(const uint4*)(kg2 + 32 * 128);
          av0 = *(const uint4*)vg2; av1 = *(const uint4*)(vg2 + (size_t)64 * Lseq);
        }
#pragma unroll
        for (int kb2 = 0; kb2 < 2; ++kb2) {
          bf16x8 kf[4];
#pragma unroll
          for (int s = 0; s < 4; ++s) kf[s] = *(const bf16x8*)(ksr + kb2 * 32 * KSTR + s * 16);
          bf16x8 vf[2][2];
#pragma unroll
          for (int db = 0; db < 2; ++db)
#pragma unroll
            for (int s2 = 0; s2 < 2; ++s2) {
              const u16* vp = vsr + db * 32 * VTSTR + kb2 * 32 + s2 * 16;
              const uint2 lo = *(const uint2*)vp, hh2 = *(const uint2*)(vp + 8);
              uint4 u; u.x = lo.x; u.y = lo.y; u.z = hh2.x; u.w = hh2.y;
              vf[db][s2] = __builtin_bit_cast(bf16x8, u);
            }
          const unsigned mb = mq[kt * 2 + kb2] >> (4 * hi);
#pragma unroll
          for (int j = 0; j < 2; ++j) {
            f32x16 st;
#pragma unroll
            for (int r = 0; r < 16; ++r) st[r] = 0.f;
#pragma unroll
            for (int s = 0; s < 4; ++s) st = MFMA32(kf[s], qf[j][s], st);
            float ps = 0.f;
#pragma unroll
            for (int r = 0; r < 16; ++r) {
              const float ex = __builtin_amdgcn_exp2f(st[r]);
              const float pv = (mb & (1u << ((r & 3) + 8 * (r >> 2)))) ? ex : 0.f;
              st[r] = pv; ps += pv;
            }
            l_[j] += ps;
#pragma unroll
            for (int s2 = 0; s2 < 2; ++s2) {
              uint4 u;
              u.x = pack2(st[8 * s2 + 0], st[8 * s2 + 1]); u.y = pack2(st[8 * s2 + 2], st[8 * s2 + 3]);
              u.z = pack2(st[8 * s2 + 4], st[8 * s2 + 5]); u.w = pack2(st[8 * s2 + 6], st[8 * s2 + 7]);
              const bf16x8 pf = __builtin_bit_cast(bf16x8, u);
#pragma unroll
              for (int db = 0; db < 2; ++db) o[j][db] = MFMA32(vf[db][s2], pf, o[j][db]);
            }
            __builtin_amdgcn_sched_barrier(0);
          }
        }
      }
#pragma unroll
      for (int j = 0; j < 2; ++j) {
        const int hh = hp * 2 + j;
        const float lt = l_[j] + __shfl_xor(l_[j], 32);
        const float inv = 1.f / lt;
#pragma unroll
        for (int db = 0; db < 2; ++db)
#pragma unroll
          for (int rg = 0; rg < 4; ++rg) {
            const int col = hh * 64 + db * 32 + 8 * rg + 4 * hi;
            const uint2 gg = *(const uint2*)(P + (size_t)qtok * PSE + C_GA + col);
            const float g0 = bf2f((u16)(gg.x & 0xffff)), g1 = bf2f((u16)(gg.x >> 16)), g2 = bf2f((u16)(gg.y & 0xffff)), g3 = bf2f((u16)(gg.y >> 16));
            uint2 ov;
            ov.x = pack2(o[j][db][4 * rg + 0] * inv * g0, o[j][db][4 * rg + 1] * inv * g1);
            ov.y = pack2(o[j][db][4 * rg + 2] * inv * g2, o[j][db][4 * rg + 3] * inv * g3);
            *(uint2*)(AB + (size_t)qtok * 1024 + col) = ov;
          }
      }
    }
    __syncthreads();
  }
}

constexpr int VSTR = 136;
DI void phase_sgu(const PV& p, Blk B, int o, unsigned char* lds, int tid) {
  const int lane = tid & 63, wave = tid >> 6, l31 = lane & 31, hi = lane >> 5;
  const u16* P = (const u16*)(p.wsp() + WS_P);
  u16* Mo = (u16*)(p.wsp() + WS_H);
  const u16* WSB = (const u16*)(p.wsp() + WS_WSB) + (size_t)o * 8 * 128 * 128;
  const float* bs = p.inp(I_ODBS) + (size_t)o * 8 * 128;
  const float* lng = p.inp(I_ODLNG) + (size_t)o * 1024;
  const float* lnb = p.inp(I_ODLNB) + (size_t)o * 1024;
  float* out = p.outp();
  u16* vnT = (u16*)lds;
  float* MU = (float*)(lds + 128 * CST * 4);
  float* RS = MU + 128;
  float* LNG = RS + 128;
  for (int i = tid; i < 1024; i += NTHREADS) { LNG[i] = lng[i]; LNG[1024 + i] = lnb[i]; }
  constexpr int NITEMS = 256 + 64;
  for (int it = B.bid; it < NITEMS; it += B.nb) {
    const bool smp = it >= 256;
    const int si = smp ? (it - 256) >> 3 : 0;
    const int tokb = smp ? NTOK_P + si * 64 : it * 128;
    const int valid = smp ? 64 : 128;
    const int g_lo = smp ? (it - 256) & 7 : 0, g_hi = smp ? g_lo + 1 : 8;
#pragma unroll 1
    for (int half = 0; half < 2; ++half) {
      uint4 va[8], vb[8];
#pragma unroll
      for (int rr = 0; rr < 8; ++rr) {
        const int j = wave * 16 + half * 8 + rr;
        const u16* vr = P + (size_t)(tokb + (j < valid ? j : 0)) * PSO + 1024 + lane * 16;
        va[rr] = *(const uint4*)vr; vb[rr] = *(const uint4*)(vr + 8);
      }
#pragma unroll
      for (int rr = 0; rr < 8; ++rr) {
        const int j = wave * 16 + half * 8 + rr;
        const unsigned w[8] = {va[rr].x, va[rr].y, va[rr].z, va[rr].w, vb[rr].x, vb[rr].y, vb[rr].z, vb[rr].w};
        float sm = 0.f, s2 = 0.f;
#pragma unroll
        for (int i = 0; i < 8; ++i) {
          const float f0 = bf2f((u16)(w[i] & 0xffff)), f1 = bf2f((u16)(w[i] >> 16));
          sm += f0 + f1; s2 += f0 * f0 + f1 * f1;
        }
        sm = wave_sum(sm); s2 = wave_sum(s2);
        const float mu = sm * (1.f / 1024.f);
        const float var = fmaxf(s2 * (1.f / 1024.f) - mu * mu, 0.f);
        if (lane == 0 && j < valid) { MU[j] = mu; RS[j] = rsqrtf(var + 1e-6f); }
      }
    }
    __syncthreads();
    const int ib = wave & 3, ch = wave >> 2;
    const int ns = (ib + 1) * 2;
    int tid_g = tid;
    asm volatile("" : "+v"(tid_g));
    const int jb = tid_g >> 2, c0 = (tid_g & 3) * 32;
    const int l31 = tid_g & 31, hi = (tid_g >> 5) & 1;
    uint4 vr4[4];
    bf16x8 wa[8];
    uint2 uu[8];
    float bbv[8];
#define LOAD_V(gx) do { const u16* vr_ = P + (size_t)(tokb + (jb < valid ? jb : 0)) * PSO + 1024 + (gx) * 128 + c0; \
      _Pragma("unroll") for (int q = 0; q < 4; ++q) vr4[q] = *(const uint4*)(vr_ + q * 8); } while (0)
#define LOAD_W(gx) do { const u16* wr_ = WSB + ((size_t)(gx) * 128 + ib * 32 + l31) * 128 + hi * 8; \
      _Pragma("unroll") for (int s2 = 0; s2 < 8; ++s2) wa[s2] = *(const bf16x8*)(wr_ + (s2 < ns ? s2 : 0) * 16); } while (0)
#define LOAD_U(gx) do { _Pragma("unroll") for (int i2 = 0; i2 < 8; ++i2) { \
        const int idx_ = tid_g + NTHREADS * i2, row_ = idx_ >> 5, c_ = (idx_ & 31) * 4; \
        const int rr_ = row_ < valid ? row_ : 0; \
        uu[i2] = *(const uint2*)(P + (size_t)(tokb + rr_) * PSO + (gx) * 128 + c_);     \
        bbv[i2] = bs[(gx) * 128 + rr_]; } } while (0)
    LOAD_V(g_lo); LOAD_W(g_lo); LOAD_U(g_lo);
#pragma unroll 1
    for (int g = g_lo; g < g_hi; ++g) {
      if (jb < valid) {
        const float mu = MU[jb], rs = RS[jb];
#pragma unroll
        for (int q = 0; q < 4; ++q) {
          const unsigned w[4] = {vr4[q].x, vr4[q].y, vr4[q].z, vr4[q].w};
          const float4 ga = *(const float4*)(LNG + g * 128 + c0 + q * 8), gb2 = *(const float4*)(LNG + g * 128 + c0 + q * 8 + 4);
          const float4 ba = *(const float4*)(LNG + 1024 + g * 128 + c0 + q * 8), bb2 = *(const float4*)(LNG + 1024 + g * 128 + c0 + q * 8 + 4);
          const float gg[8] = {ga.x, ga.y, ga.z, ga.w, gb2.x, gb2.y, gb2.z, gb2.w};
          const float bbw[8] = {ba.x, ba.y, ba.z, ba.w, bb2.x, bb2.y, bb2.z, bb2.w};
          float f[8];
#pragma unroll
          for (int i = 0; i < 4; ++i) {
            f[2 * i] = (bf2f((u16)(w[i] & 0xffff)) - mu) * rs * gg[2 * i] + bbw[2 * i];
            f[2 * i + 1] = (bf2f((u16)(w[i] >> 16)) - mu) * rs * gg[2 * i + 1] + bbw[2 * i + 1];
          }
#pragma unroll
          for (int i = 0; i < 8; ++i) vnT[(c0 + q * 8 + i) * VSTR + jb] = f2bf(f[i]);
          if (smp) {
            float* oc = out + O_CV + (((size_t)o * 8 + si) * 64 + jb) * 1024 + g * 128 + c0 + q * 8;
            *(float4*)oc = make_float4(f[0], f[1], f[2], f[3]);
            *(float4*)(oc + 4) = make_float4(f[4], f[5], f[6], f[7]);
          }
        }
      } else {
#pragma unroll
        for (int c = 0; c < 32; ++c) vnT[(c0 + c) * VSTR + jb] = 0;
      }
      if (g + 1 < g_hi) LOAD_V(g + 1);
      __syncthreads();
      f32x16 acc[2];
#pragma unroll
      for (int r = 0; r < 16; ++r) { acc[0][r] = 0.f; acc[1][r] = 0.f; }
      if (ib * 32 < valid) {
        const u16* b0p = vnT + (ch * 64 + l31) * VSTR + hi * 8;
#pragma unroll
        for (int s2 = 0; s2 < 8; ++s2) {
          if (s2 < ns) {
            const bf16x8 b0 = *(const bf16x8*)(b0p + s2 * 16), b1 = *(const bf16x8*)(b0p + 32 * VSTR + s2 * 16);
            acc[0] = MFMA32(wa[s2], b0, acc[0]);
            acc[1] = MFMA32(wa[s2], b1, acc[1]);
          }
        }
      }
      if (g + 1 < g_hi) LOAD_W(g + 1);
      __syncthreads();
      float* Cs = (float*)lds;
#pragma unroll
      for (int nb2 = 0; nb2 < 2; ++nb2)
#pragma unroll
        for (int r = 0; r < 16; ++r)
          Cs[(ib * 32 + (r & 3) + 8 * (r >> 2) + 4 * hi) * CST + ch * 64 + nb2 * 32 + l31] = acc[nb2][r];
      __syncthreads();
#pragma unroll
      for (int i2 = 0; i2 < 8; ++i2) {
        const int idx = tid_g + NTHREADS * i2, row = idx >> 5, c = (idx & 31) * 4;
        if (row < valid) {
          const size_t tk = (size_t)(tokb + row);
          const float4 sv = *(const float4*)(Cs + row * CST + c);
          const float bb = bbv[i2];
          const uint2 u2 = uu[i2];
          uint2 ov;
          ov.x = pack2(bf2f((u16)(u2.x & 0xffff)) * (sv.x + bb), bf2f((u16)(u2.x >> 16)) * (sv.y + bb));
          ov.y = pack2(bf2f((u16)(u2.y & 0xffff)) * (sv.z + bb), bf2f((u16)(u2.y >> 16)) * (sv.w + bb));
          *(uint2*)(Mo + tk * 1024 + g * 128 + c) = ov;
        }
      }
      if (g + 1 < g_hi) LOAD_U(g + 1);
      __syncthreads();
    }
#undef LOAD_V
#undef LOAD_W
#undef LOAD_U
  }
}

#define XB_TMO      128
#define XB_XCNT(j)  (256  + 64 * (j))
#define XB_XSUB(j)  (1280 + 64 * (j))
#define XB_XGEN(j)  (2304 + 64 * (j))
#define XB_TOP      3328
#define XB_TOPGEN   3392
#define XCD_BAR_WORDS 3456
#define XB_SPIN_CAP (1u << 18)
#define LAS __attribute__((address_space(3)))
DI unsigned xb_ld(unsigned* p)              { return __hip_atomic_load(p, __ATOMIC_RELAXED, __HIP_MEMORY_SCOPE_AGENT); }
DI unsigned xb_add(unsigned* p, unsigned v) { return __hip_atomic_fetch_add(p, v, __ATOMIC_RELAXED, __HIP_MEMORY_SCOPE_AGENT); }
DI unsigned xb_xcc_id() { return (unsigned)__builtin_amdgcn_s_getreg((3 << 11) | 20) & 0xFu; }
#define XB_SPIN(cond, bar) do { unsigned _sp = 0; while (cond) { __builtin_amdgcn_s_sleep(1); \
    if ((++_sp & 255u) == 0u) { if (xb_ld(&(bar)[XB_TMO])) break; if (_sp > XB_SPIN_CAP) { atomicAdd(&(bar)[XB_TMO], 1u); break; } } } } while (0)
struct XcdBarrier { unsigned* bar; unsigned x; volatile LAS unsigned* st; };
DI XcdBarrier xcd_barrier_post(unsigned* bar, volatile LAS unsigned* st) {
  XcdBarrier b; b.bar = bar; b.x = xb_xcc_id(); b.st = st;
  if (threadIdx.x == 0) (void)xb_add(&bar[XB_XCNT(b.x)], 1u);
  return b;
}
DI void xcd_barrier_complete(unsigned* bar, unsigned x, unsigned& nloc, unsigned& nx) {
  const unsigned G = gridDim.x * gridDim.y * gridDim.z;
  unsigned sum, cnt, mine, sp = 0u;
  for (;;) {
    sum = 0u; cnt = 0u; mine = 0u;
#pragma unroll
    for (unsigned j = 0; j < 16; ++j) { const unsigned c = xb_ld(&bar[XB_XCNT(j)]); sum += c; cnt += (c > 0u) ? 1u : 0u; mine = (j == x) ? c : mine; }
    if (sum == G) break;
    __builtin_amdgcn_s_sleep(1);
    if ((++sp & 255u) == 0u) { if (xb_ld(&bar[XB_TMO])) break; if (sp > XB_SPIN_CAP) { atomicAdd(&bar[XB_TMO], 1u); break; } }
  }
  nloc = mine > 0u ? mine : 1u; nx = cnt > 0u ? cnt : 1u;
}
DI void xcd_barrier(const XcdBarrier& b) {
  asm volatile("s_waitcnt vmcnt(0)" ::: "memory");
  __syncthreads();
  if (threadIdx.x == 0) {
    unsigned* bar = b.bar;
    __builtin_amdgcn_s_waitcnt(0);
    unsigned nloc = b.st[0], nx = b.st[1];
    if (nloc == 0u) { xcd_barrier_complete(bar, b.x, nloc, nx); b.st[0] = nloc; b.st[1] = nx; }
    const unsigned old = xb_add(&bar[XB_XSUB(b.x)], 1u);
    const unsigned gen = old / nloc;
    if (old + 1u == (gen + 1u) * nloc) {
      __builtin_amdgcn_fence(__ATOMIC_RELEASE, "agent");
      asm volatile("s_waitcnt vmcnt(0)" ::: "memory");
      const unsigned og = xb_add(&bar[XB_TOP], 1u);
      const unsigned tg = og / nx;
      if (og + 1u == (tg + 1u) * nx) xb_add(&bar[XB_TOPGEN], 1u);
      else XB_SPIN(xb_ld(&bar[XB_TOPGEN]) == tg, bar);
      __builtin_amdgcn_fence(__ATOMIC_ACQUIRE, "agent");
      xb_add(&bar[XB_XGEN(b.x)], 1u);
      asm volatile("s_waitcnt vmcnt(0)" ::: "memory");
    } else {
      XB_SPIN(xb_ld(&bar[XB_XGEN(b.x)]) == gen, bar);
      __builtin_amdgcn_fence(__ATOMIC_ACQUIRE, "agent");
      asm volatile("s_waitcnt vmcnt(0)" ::: "memory");
    }
  }
  __syncthreads();
}

constexpr int NPHASES = 18;
DI void run_phase(const PV& p, Blk B, int ph, unsigned char* lds, int tid) {
  if (ph == 0) { phase_prologue(p, B, lds, tid); return; }
  if (ph == 17) { phase_norm(p, B, 0, true, tid); return; }
  const int l = (ph - 1) >> 2, s = (ph - 1) & 3;
  if (s == 0) phase_norm(p, B, l, false, tid);
  else if (s == 1) { if (l & 1) phase_gemm_odd_in(p, B, l >> 1, lds, tid); else phase_gemm_even_in(p, B, l >> 1, lds, tid); }
  else if (s == 2) { if (l & 1) phase_sgu(p, B, l >> 1, lds, tid); else phase_attn(p, B, l >> 1, lds, tid); }
  else phase_gemm_out(p, B, l, lds, tid);
}

template <bool COOP>
__global__ void __launch_bounds__(NTHREADS) mk_fwd(Params p, int ph_lo, int ph_hi) {
  extern __shared__ __attribute__((aligned(16))) unsigned char lds[];
  XcdBarrier xbar; xbar.bar = nullptr; xbar.x = 0; xbar.st = nullptr;
  if (COOP) {
    volatile LAS unsigned* st = (volatile LAS unsigned*)(LAS unsigned char*)(lds + LDS_BYTES - 32);
    if (threadIdx.x == 0) { st[0] = 0u; st[1] = 0u; }
    __syncthreads();
    xbar = xcd_barrier_post((unsigned*)(p.ws + WS_BAR), st);
  }
  for (int ph = ph_lo; ph < ph_hi; ++ph) {
    int t2 = threadIdx.x;
    Blk B; B.bid = blockIdx.x; B.nb = gridDim.x;
    PV q; q.k = (kaptr)__builtin_amdgcn_kernarg_segment_ptr();
    asm volatile("" : "+v"(t2), "+s"(B.bid), "+s"(B.nb), "+s"(q.k));
    run_phase(q, B, ph, lds, t2);
#if REPEAT_KINDS
    {
      const int sk = (ph - 1) & 3, lk = (ph - 1) >> 2;
      bool again = false;
      if (ph >= 1 && ph <= 16) {
        if (sk == 1 && (REPEAT_KINDS & 1)) again = true;
        if (sk == 2 && !(lk & 1) && (REPEAT_KINDS & 2)) again = true;
        if (sk == 2 && (lk & 1) && (REPEAT_KINDS & 4)) again = true;
        if (sk == 0 && (REPEAT_KINDS & 8)) again = true;
      }
      if (again) { __syncthreads(); run_phase(q, B, ph, lds, t2); }
    }
#endif
    if (COOP) { if (ph + 1 < ph_hi) { if (ph == 0) cg::this_grid().sync(); else xcd_barrier(xbar); } }
  }
}

template <int KIND>
__global__ void __launch_bounds__(NTHREADS) k_phase(Params p, int a) {
  extern __shared__ __attribute__((aligned(16))) unsigned char lds[];
  const int tid = threadIdx.x;
  Blk B; B.bid = blockIdx.x; B.nb = gridDim.x;
  PV q; q.k = (kaptr)__builtin_amdgcn_kernarg_segment_ptr();
  if (KIND == 0) phase_prologue(q, B, lds, tid);
  else if (KIND == 1) phase_norm(q, B, a, false, tid);
  else if (KIND == 2) phase_gemm_even_in(q, B, a, lds, tid);
  else if (KIND == 3) phase_gemm_odd_in(q, B, a, lds, tid);
  else if (KIND == 4) phase_attn(q, B, a, lds, tid);
  else if (KIND == 5) phase_sgu(q, B, a, lds, tid);
  else if (KIND == 6) phase_gemm_out(q, B, a, lds, tid);
  else phase_norm(q, B, 0, true, tid);
}
template <int KIND>
static void launch_phase(const Params& p, int a, int grid, hipStream_t stream) {
  static bool attr_set = false;
  if (!attr_set) { (void)hipFuncSetAttribute((const void*)k_phase<KIND>, hipFuncAttributeMaxDynamicSharedMemorySize, LDS_BYTES); attr_set = true; }
  hipLaunchKernelGGL(k_phase<KIND>, dim3(grid), dim3(NTHREADS), LDS_BYTES, stream, p, a);
}

extern "C" void kernel_launch(void* const* d_in, const int* in_sizes, int n_in, void* d_out, int out_size, void* d_ws, size_t ws_size, hipStream_t stream) {
  static int grid = 0;
  if (grid == 0) {
    if (ws_size < WS_END) { fprintf(stderr, "kernel_launch: workspace too small: %zu < %zu\n", ws_size, (size_t)WS_END); grid = -1; return; }
    int dev = 0, cus = 0, per_cu = 0;
    (void)hipGetDevice(&dev);
    (void)hipDeviceGetAttribute(&cus, hipDeviceAttributeMultiprocessorCount, dev);
#if ONE_LAUNCH
    (void)hipFuncSetAttribute((const void*)mk_fwd<true>, hipFuncAttributeMaxDynamicSharedMemorySize, LDS_BYTES);
    (void)hipOccupancyMaxActiveBlocksPerMultiprocessor(&per_cu, (const void*)mk_fwd<true>, NTHREADS, LDS_BYTES);
#else
    per_cu = 1;
#endif
    if (per_cu < 1) { fprintf(stderr, "kernel_launch: occupancy query gave %d\n", per_cu); grid = -1; return; }
    grid = cus * per_cu;
    if (grid > MAXGRID) grid = MAXGRID;
  }
  if (grid < 0) return;
  Params p{};
  for (int i = 0; i < 21; ++i) p.in[i] = (const float*)d_in[i];
  p.out = (float*)d_out;
  p.ws = (unsigned char*)d_ws;
#if ONE_LAUNCH
  (void)hipMemsetAsync((unsigned char*)d_ws + WS_BAR, 0, XCD_BAR_BYTES, stream);
  int lo = 0, hi = NPHASES;
  void* args[] = {&p, &lo, &hi};
  hipError_t e = hipLaunchCooperativeKernel((const void*)mk_fwd<true>, dim3(grid), dim3(NTHREADS), args, LDS_BYTES, stream);
  if (e != hipSuccess) fprintf(stderr, "cooperative launch failed: %s (grid %d)\n", hipGetErrorString(e), grid);
#else
  launch_phase<0>(p, 0, grid, stream);
  for (int l = 0; l < 4; ++l) {
    launch_phase<1>(p, l, grid, stream);
    if (l & 1) { launch_phase<3>(p, l >> 1, grid, stream); launch_phase<5>(p, l >> 1, grid, stream); }
    else { launch_phase<2>(p, l >> 1, grid, stream); launch_phase<4>(p, l >> 1, grid, stream); }
    launch_phase<6>(p, l, grid, stream);
  }
  launch_phase<7>(p, 0, grid, stream);
#endif
}
```

```cpp
#include <hip/hip_runtime.h>
#include <hip/hip_cooperative_groups.h>
#include <cstdio>
namespace cg = cooperative_groups;

#ifndef REPEAT_KINDS
#define REPEAT_KINDS 0
#endif
#ifndef ATT_REP
#define ATT_REP 0
#endif
#ifndef GEMM_REP
#define GEMM_REP 0
#endif
#ifndef ONE_LAUNCH
#define ONE_LAUNCH 1
#endif

typedef unsigned short u16;
typedef unsigned long long u64;
typedef __attribute__((ext_vector_type(8))) short bf16x8;
typedef __attribute__((ext_vector_type(16))) float f32x16;
typedef __attribute__((ext_vector_type(4))) float f32x4;
#define DI __device__ __forceinline__
#define MFMA32(a, b, c) __builtin_amdgcn_mfma_f32_32x32x16_bf16((a), (b), (c), 0, 0, 0)
#define MFMA16(a, b, c) __builtin_amdgcn_mfma_f32_16x16x32_bf16((a), (b), (c), 0, 0, 0)

constexpr int D = 1024;
constexpr int NTOK_P = 32768, NTOK_S = 512, NTOK = NTOK_P + NTOK_S;
constexpr int WE_ROWS = 4096;
constexpr int PSE = 2560;
constexpr int C_Q = 0, C_GA = 512, C_QI = 1024, C_Z = 1536, C_GBZ = 2048;
constexpr int WO_ROWS = 3072;
constexpr int PSO = 2048;
constexpr int KROWS = 32768 + 8 * 1088;
constexpr int NTHREADS = 512;
constexpr int MAXGRID = 256;

constexpr size_t O_Y = 0, O_KP = 34078720, O_VP = 42467328, O_KIP = 50855936, O_CVP = 55050240, O_KS = 55083008,
                 O_VS = 55214080, O_KIS = 55345152, O_CVS = 55410688, O_CV = 55427072;

constexpr size_t XCD_BAR_BYTES = 3456 * 4;
constexpr size_t WS_MOD = 0;
constexpr size_t WS_WI = WS_MOD + 4ull * 24 * 3072 * 4;
constexpr size_t WS_WSB = WS_WI + (size_t)NTOK * 8 * 4;
constexpr size_t WS_WEIN = WS_WSB + 2ull * 8 * 128 * 128 * 2;
constexpr size_t WS_WEOUT = WS_WEIN + 2ull * WE_ROWS * 1024 * 2;
constexpr size_t WS_WOIN = WS_WEOUT + 2ull * 1024 * 1024 * 2;
constexpr size_t WS_WOOUT = WS_WOIN + 2ull * 3072 * 1024 * 2;
constexpr size_t WS_KB = WS_WOOUT + 2ull * 1024 * 1024 * 2;
constexpr size_t WS_VT = WS_KB + 2ull * KROWS * 128 * 2;
constexpr size_t WS_KI = WS_VT + 2ull * KROWS * 128 * 2;
constexpr size_t WS_H = WS_KI + 2ull * KROWS * 64 * 2;
constexpr size_t WS_SC = WS_H + (size_t)NTOK * 1024 * 2;
constexpr size_t WS_P = WS_SC + (size_t)MAXGRID * 64 * 2048 * 2;
constexpr size_t WS_CTR = WS_P + (size_t)NTOK * 3072 * 2;
constexpr size_t WS_BAR = WS_CTR + 256;
constexpr size_t WS_END = WS_BAR + XCD_BAR_BYTES;

constexpr int LDS_BYTES = 148 * 1024;

struct Params {
  const float* in[21];
  float* out;
  unsigned char* ws;
};
struct Blk { int bid, nb; };
typedef const __attribute__((address_space(4))) unsigned char* kaptr;
struct PV {
  kaptr k;
  DI const float* inp(int i) const { return *(const float* const __attribute__((address_space(4)))*)(k + 8 * i); }
  DI float* outp() const { return *(float* const __attribute__((address_space(4)))*)(k + 8 * 21); }
  DI unsigned char* wsp() const { return *(unsigned char* const __attribute__((address_space(4)))*)(k + 8 * 22); }
};
enum { I_XP = 0, I_XS, I_CK, I_CV, I_CKI, I_SCONV, I_CP, I_CS, I_ADAW, I_ADAB, I_NORMG, I_EVWIN, I_EVCONV, I_EVWOUT, I_ODWIN, I_ODWS, I_ODBS, I_ODLNG, I_ODLNB, I_ODWOUT, I_FINALG };

DI u16 f2bf(float x) { __bf16 b = (__bf16)x; return __builtin_bit_cast(u16, b); }
DI float bf2f(u16 h) { return __uint_as_float(((unsigned)h) << 16); }
DI unsigned pack2(float a, float b) { return (unsigned)f2bf(a) | ((unsigned)f2bf(b) << 16); }
DI float silu_f(float x) { return x * __builtin_amdgcn_rcpf(1.f + __expf(-x)); }
DI float gelu_f(float x) {
  float u = 0.7978845608028654f * (x + 0.044715f * x * x * x);
  float t = 1.f - 2.f * __builtin_amdgcn_rcpf(__expf(2.f * u) + 1.f);
  return 0.5f * x * (1.f + t);
}
DI int mod_row(int tok) { return tok < NTOK_P ? (tok >> 11) : 16 + ((tok - NTOK_P) >> 6); }
DI int key_row(int tok) { return tok < NTOK_P ? tok : NTOK_P + ((tok - NTOK_P) >> 6) * 1088 + 1024 + ((tok - NTOK_P) & 63); }
DI float wave_sum(float v) {
#pragma unroll
  for (int o = 32; o > 0; o >>= 1) v += __shfl_xor(v, o);
  return v;
}

template <class Map>
DI void transpose_tile(const float* __restrict__ src, int ldsrc, u16* __restrict__ dst, int n0, int k0, Map map, float* tile, int tid) {
  const int c = tid & 63, r0 = tid >> 6;
  const int sc = map(n0 + c);
#pragma unroll
  for (int i = 0; i < 8; ++i) {
    const int r = r0 + 8 * i;
    tile[c * 65 + r] = sc >= 0 ? src[(size_t)(k0 + r) * ldsrc + sc] : 0.f;
  }
  __syncthreads();
  const int n = tid >> 3, ch = tid & 7;
  const float* t = tile + n * 65 + ch * 8;
  uint4 v;
  v.x = pack2(t[0], t[1]); v.y = pack2(t[2], t[3]); v.z = pack2(t[4], t[5]); v.w = pack2(t[6], t[7]);
  *(uint4*)(dst + (size_t)(n0 + n) * 1024 + k0 + ch * 8) = v;
  __syncthreads();
}

struct MapEvenIn { DI int operator()(int n) const {
  if (n < 1864) return n;
  if (n < 2048) return -1;
  const int m = n - 2048, j = (m >> 8) & 3, w = m & 255;
  if (m < 1024) return w < 128 ? 2376 + j * 128 + w : 2888 + j * 128 + (w - 128);
  return w < 128 ? 1864 + j * 128 + w : 3400 + j * 128 + (w - 128);
} };
struct MapOddIn { DI int operator()(int n) const {
  if (n < 2048) { const int j = n >> 8, w = n & 255; return w < 128 ? j * 128 + w : 2048 + j * 128 + (w - 128); }
  return 1024 + (n - 2048);
} };
struct MapId { DI int operator()(int n) const { return n; } };

DI void phase_prologue(const PV& p, Blk B, unsigned char* lds, int tid) {
  const int nb = B.nb, bid = B.bid;
  float* ldsf = (float*)lds;
  constexpr int N_MOD = 192;
  constexpr int T_EIN = 64 * 16;
  constexpr int T_EOUT = 16 * 16;
  constexpr int T_OIN = 48 * 16;
  constexpr int T_OOUT = 16 * 16;
  constexpr int N_T = 2 * (T_EIN + T_EOUT + T_OIN + T_OOUT);
  for (int it = bid; it < N_MOD + N_T; it += nb) {
    if (it < N_MOD) {
      const int l = it / 48, cc = it % 48;
      for (int i = tid; i < 24 * 1024; i += NTHREADS) {
        const int r = i >> 10, k = i & 1023;
        const float c = r < 16 ? p.inp(I_CP)[r * 1024 + k] : p.inp(I_CS)[(r - 16) * 1024 + k];
        ldsf[i] = silu_f(c);
      }
      __syncthreads();
      const int kg = tid >> 6, nl = tid & 63;
      float acc[24];
#pragma unroll
      for (int r = 0; r < 24; ++r) acc[r] = 0.f;
      const float* w = p.inp(I_ADAW) + (size_t)l * 1024 * 3072 + cc * 64 + nl;
      for (int k = kg * 128; k < kg * 128 + 128; k += 8) {
        float wv[8];
#pragma unroll
        for (int u = 0; u < 8; ++u) wv[u] = w[(size_t)(k + u) * 3072];
#pragma unroll
        for (int u = 0; u < 8; ++u)
#pragma unroll
          for (int r = 0; r < 24; ++r) acc[r] += ldsf[r * 1024 + k + u] * wv[u];
      }
      __syncthreads();
#pragma unroll
      for (int r = 0; r < 24; ++r) ldsf[(kg * 24 + r) * 64 + nl] = acc[r];
      __syncthreads();
      for (int i = tid; i < 24 * 64; i += NTHREADS) {
        const int r = i >> 6, n = i & 63;
        float s = 0.f;
#pragma unroll
        for (int g = 0; g < 8; ++g) s += ldsf[(g * 24 + r) * 64 + n];
        const int col = cc * 64 + n;
        ((float*)(p.wsp() + WS_MOD))[((size_t)l * 24 + r) * 3072 + col] = s + p.inp(I_ADAB)[l * 3072 + col];
      }
      __syncthreads();
    } else {
      int t = it - N_MOD;
      const int e = t / (T_EIN + T_EOUT + T_OIN + T_OOUT);
      t -= e * (T_EIN + T_EOUT + T_OIN + T_OOUT);
      if (t < T_EIN) {
        transpose_tile(p.inp(I_EVWIN) + (size_t)e * 1024 * 3912, 3912, (u16*)(p.wsp() + WS_WEIN) + (size_t)e * WE_ROWS * 1024, (t >> 4) * 64, (t & 15) * 64, MapEvenIn(), ldsf, tid);
      } else if ((t -= T_EIN) < T_EOUT) {
        transpose_tile(p.inp(I_EVWOUT) + (size_t)e * 1024 * 1024, 1024, (u16*)(p.wsp() + WS_WEOUT) + (size_t)e * 1024 * 1024, (t >> 4) * 64, (t & 15) * 64, MapId(), ldsf, tid);
      } else if ((t -= T_EOUT) < T_OIN) {
        transpose_tile(p.inp(I_ODWIN) + (size_t)e * 1024 * 3072, 3072, (u16*)(p.wsp() + WS_WOIN) + (size_t)e * 3072 * 1024, (t >> 4) * 64, (t & 15) * 64, MapOddIn(), ldsf, tid);
      } else {
        t -= T_OIN;
        transpose_tile(p.inp(I_ODWOUT) + (size_t)e * 1024 * 1024, 1024, (u16*)(p.wsp() + WS_WOOUT) + (size_t)e * 1024 * 1024, (t >> 4) * 64, (t & 15) * 64, MapId(), ldsf, tid);
      }
    }
  }
  const int gt = bid * NTHREADS + tid, gs = nb * NTHREADS;
  if (gt < 64) ((unsigned*)(p.wsp() + WS_CTR))[gt] = 0u;
  {
    u16* wsb = (u16*)(p.wsp() + WS_WSB);
    for (int i = gt; i < 2 * 8 * 128 * 128; i += gs) {
      const int jj = i & 127, ii = (i >> 7) & 127;
      wsb[i] = f2bf(jj <= ii ? p.inp(I_ODWS)[i] : 0.f);
    }
  }
  {
    u16* kb = (u16*)(p.wsp() + WS_KB);
    for (int i = gt; i < 2 * 8 * 1024 * 16; i += gs) {
      const int c8 = i & 15, pos = (i >> 4) & 1023, b = (i >> 14) & 7, e = i >> 17;
      const float* s = p.inp(I_CK) + (size_t)i * 8;
      const float4 a = *(const float4*)s, bb = *(const float4*)(s + 4);
      uint4 v; v.x = pack2(a.x, a.y); v.y = pack2(a.z, a.w); v.z = pack2(bb.x, bb.y); v.w = pack2(bb.z, bb.w);
      *(uint4*)(kb + ((size_t)e * KROWS + NTOK_P + b * 1088 + pos) * 128 + c8 * 8) = v;
    }
    u16* ki = (u16*)(p.wsp() + WS_KI);
    for (int i = gt; i < 2 * 8 * 1024 * 8; i += gs) {
      const int c8 = i & 7, pos = (i >> 3) & 1023, b = (i >> 13) & 7, e = i >> 16;
      const float* s = p.inp(I_CKI) + (size_t)i * 8;
      const float4 a = *(const float4*)s, bb = *(const float4*)(s + 4);
      uint4 v; v.x = pack2(a.x, a.y); v.y = pack2(a.z, a.w); v.z = pack2(bb.x, bb.y); v.w = pack2(bb.z, bb.w);
      *(uint4*)(ki + ((size_t)e * KROWS + NTOK_P + b * 1088 + pos) * 64 + c8 * 8) = v;
    }
    u16* vt = (u16*)(p.wsp() + WS_VT);
    for (int i = gt; i < 2 * 8 * 128 * 128; i += gs) {
      const int c = i & 127, p8 = (i >> 7) & 127, b = (i >> 14) & 7, e = i >> 17;
      const float* s = p.inp(I_CV) + (((size_t)e * 8 + b) * 1024 + p8 * 8) * 128 + c;
      uint4 v;
      v.x = pack2(s[0], s[128]); v.y = pack2(s[256], s[384]); v.z = pack2(s[512], s[640]); v.w = pack2(s[768], s[896]);
      *(uint4*)(vt + (size_t)e * KROWS * 128 + (size_t)NTOK_P * 128 + (size_t)b * 128 * 1088 + (size_t)c * 1088 + p8 * 8) = v;
    }
  }
}

DI void phase_norm(const PV& p, Blk B, int layer, bool final_, int tid) {
  const int lane = tid & 63, wave = tid >> 6;
  float* X = p.outp();
  u16* H = (u16*)(p.wsp() + WS_H);
  const float* gam = final_ ? p.inp(I_FINALG) : p.inp(I_NORMG) + layer * 1024;
  const float* modl = (const float*)(p.wsp() + WS_MOD) + (size_t)(final_ ? 0 : layer) * 24 * 3072;
  const int step = B.nb * 32;
  int tok0 = (B.bid * 8 + wave) * 4;
  float4 v[4][4], vn[4][4];
#define XROWS(dst, t0) do { _Pragma("unroll") for (int t = 0; t < 4; ++t) { \
      const int tok_ = (t0) + t; const float* xr_; \
      if (layer == 0 && !final_) xr_ = tok_ < NTOK_P ? p.inp(I_XP) + (size_t)tok_ * 1024 : p.inp(I_XS) + (size_t)(tok_ - NTOK_P) * 1024; \
      else xr_ = X + (size_t)tok_ * 1024; \
      _Pragma("unroll") for (int i = 0; i < 4; ++i) dst[t][i] = *(const float4*)(xr_ + i * 256 + lane * 4); } } while (0)
  if (tok0 < NTOK) XROWS(v, tok0);
  for (; tok0 < NTOK; tok0 += step) {
    float4 g4[4], sh[4], sc[4];
    const float* mr = modl + (size_t)mod_row(tok0) * 3072;
    const int tokn = tok0 + step;
    if (tokn < NTOK) XROWS(vn, tokn);
#pragma unroll
    for (int i = 0; i < 4; ++i) {
      const int c = i * 256 + lane * 4;
      g4[i] = *(const float4*)(gam + c);
      if (!final_) { sh[i] = *(const float4*)(mr + c); sc[i] = *(const float4*)(mr + 1024 + c); }
    }
    float ss[4] = {0.f, 0.f, 0.f, 0.f};
#pragma unroll
    for (int t = 0; t < 4; ++t) {
#pragma unroll
      for (int i = 0; i < 4; ++i) ss[t] += v[t][i].x * v[t][i].x + v[t][i].y * v[t][i].y + v[t][i].z * v[t][i].z + v[t][i].w * v[t][i].w;
    }
#pragma unroll
    for (int o = 32; o > 0; o >>= 1) {
#pragma unroll
      for (int t = 0; t < 4; ++t) ss[t] += __shfl_xor(ss[t], o);
    }
#pragma unroll
    for (int t = 0; t < 4; ++t) {
      const int tok = tok0 + t;
      const float rs = rsqrtf(ss[t] * (1.f / 1024.f) + 1e-6f);
#pragma unroll
      for (int i = 0; i < 4; ++i) {
        const int c = i * 256 + lane * 4;
        float4 y;
        y.x = v[t][i].x * rs * g4[i].x; y.y = v[t][i].y * rs * g4[i].y; y.z = v[t][i].z * rs * g4[i].z; y.w = v[t][i].w * rs * g4[i].w;
        if (final_) {
          *(float4*)(X + (size_t)tok * 1024 + c) = y;
        } else {
          uint2 o;
          o.x = pack2(y.x * (1.f + sc[i].x) + sh[i].x, y.y * (1.f + sc[i].y) + sh[i].y);
          o.y = pack2(y.z * (1.f + sc[i].z) + sh[i].z, y.w * (1.f + sc[i].w) + sh[i].w);
          *(uint2*)(H + (size_t)tok * 1024 + c) = o;
        }
      }
    }
#pragma unroll
    for (int t = 0; t < 4; ++t)
#pragma unroll
      for (int i = 0; i < 4; ++i) v[t][i] = vn[t][i];
  }
#undef XROWS
}

constexpr int LDB = 72;
constexpr int LDS2 = 136;
constexpr int CSB = 260;
constexpr int CSS = 132;
constexpr int CST = 132;

DI void gemm_big(const u16* __restrict__ A, const u16* __restrict__ Bt, int m0, int n0, unsigned char* lds, f32x16 (&acc)[4][2], int tid_in) {
  int tid = tid_in;
  asm volatile("" : "+v"(tid));
  constexpr int STAGE = 512 * LDB;
  u16* S0 = (u16*)lds;
  const int lane = tid & 63, wave = tid >> 6, wm = wave & 1, wn = wave >> 1;
  const int l31 = lane & 31, hi = lane >> 5;
  const int lrow = tid >> 3, lch = tid & 7;
  const u16* Ap = A + (size_t)(m0 + lrow) * 1024 + lch * 8;
  const u16* Bp = Bt + (size_t)(n0 + lrow) * 1024 + lch * 8;
  uint4 ra0, ra1, ra2, ra3, rb0, rb1, rb2, rb3;
#pragma unroll
  for (int i = 0; i < 4; ++i)
#pragma unroll
    for (int j = 0; j < 2; ++j)
#pragma unroll
      for (int r = 0; r < 16; ++r) acc[i][j][r] = 0.f;
#define GLOAD(k0) do { \
    ra0 = *(const uint4*)(Ap + (k0)); ra1 = *(const uint4*)(Ap + (size_t)64 * 1024 + (k0)); \
    ra2 = *(const uint4*)(Ap + (size_t)128 * 1024 + (k0)); ra3 = *(const uint4*)(Ap + (size_t)192 * 1024 + (k0)); \
    rb0 = *(const uint4*)(Bp + (k0)); rb1 = *(const uint4*)(Bp + (size_t)64 * 1024 + (k0)); \
    rb2 = *(const uint4*)(Bp + (size_t)128 * 1024 + (k0)); rb3 = *(const uint4*)(Bp + (size_t)192 * 1024 + (k0)); } while (0)
#define LWRITE(base) do { u16* aw_ = (base) + lrow * LDB + lch * 8; u16* bw_ = aw_ + 256 * LDB; \
    *(uint4*)(aw_) = ra0; *(uint4*)(aw_ + 64 * LDB) = ra1; *(uint4*)(aw_ + 128 * LDB) = ra2; *(uint4*)(aw_ + 192 * LDB) = ra3; \
    *(uint4*)(bw_) = rb0; *(uint4*)(bw_ + 64 * LDB) = rb1; *(uint4*)(bw_ + 128 * LDB) = rb2; *(uint4*)(bw_ + 192 * LDB) = rb3; } while (0)
#define COMPUTE(base, s) do { \
    const u16* ar_ = (base) + (wm * 128 + l31) * LDB + hi * 8 + (s) * 16; \
    const u16* br_ = (base) + 256 * LDB + (wn * 64 + l31) * LDB + hi * 8 + (s) * 16; \
    const bf16x8 b0 = *(const bf16x8*)(br_), b1 = *(const bf16x8*)(br_ + 32 * LDB); \
    _Pragma("unroll") for (int mi = 0; mi < 4; ++mi) { \
      const bf16x8 a = *(const bf16x8*)(ar_ + mi * 32 * LDB); \
      acc[mi][0] = MFMA32(a, b0, acc[mi][0]); acc[mi][1] = MFMA32(a, b1, acc[mi][1]); } } while (0)
  GLOAD(0);
  __syncthreads();
  LWRITE(S0);
  GLOAD(64);
  __syncthreads();
#pragma unroll 1
  for (int kt = 0; kt < 16; ++kt) {
    u16* cur = S0 + (kt & 1) * STAGE;
    u16* nxt = S0 + ((kt & 1) ^ 1) * STAGE;
    __builtin_amdgcn_s_setprio(1);
    COMPUTE(cur, 0);
    COMPUTE(cur, 1);
    __builtin_amdgcn_s_setprio(0);
    if (kt + 1 < 16) LWRITE(nxt);
    if (kt + 2 < 16) GLOAD((kt + 2) * 64);
    __builtin_amdgcn_s_setprio(1);
    COMPUTE(cur, 2);
    COMPUTE(cur, 3);
    __builtin_amdgcn_s_setprio(0);
    __syncthreads();
  }
#undef GLOAD
#undef LWRITE
#undef COMPUTE
}

DI void gemm_small(const u16* __restrict__ A, const u16* __restrict__ Bt, int m0, int n0, unsigned char* lds, f32x16 (&acc)[2], int tid_in) {
  int tid = tid_in;
  asm volatile("" : "+v"(tid));
  constexpr int STAGE = 320 * LDB;
  u16* S0 = (u16*)lds;
  const int lane = tid & 63, wave = tid >> 6, wm = wave & 1, wn = wave >> 1;
  const int l31 = lane & 31, hi = lane >> 5;
  const int lrow = tid >> 3, lch = tid & 7;
  const u16* Ap = A + (size_t)(m0 + lrow) * 1024 + lch * 8;
  const u16* Bp = Bt + (size_t)(n0 + lrow) * 1024 + lch * 8;
  uint4 ra0, rb0, rb1, rb2, rb3;
#pragma unroll
  for (int r = 0; r < 16; ++r) { acc[0][r] = 0.f; acc[1][r] = 0.f; }
#define GLOAD(k0) do { \
    ra0 = *(const uint4*)(Ap + (k0)); \
    rb0 = *(const uint4*)(Bp + (k0)); rb1 = *(const uint4*)(Bp + (size_t)64 * 1024 + (k0)); \
    rb2 = *(const uint4*)(Bp + (size_t)128 * 1024 + (k0)); rb3 = *(const uint4*)(Bp + (size_t)192 * 1024 + (k0)); } while (0)
#define LWRITE(base) do { u16* aw_ = (base) + lrow * LDB + lch * 8; u16* bw_ = aw_ + 64 * LDB; \
    *(uint4*)(aw_) = ra0; \
    *(uint4*)(bw_) = rb0; *(uint4*)(bw_ + 64 * LDB) = rb1; *(uint4*)(bw_ + 128 * LDB) = rb2; *(uint4*)(bw_ + 192 * LDB) = rb3; } while (0)
#define COMPUTE(base, s) do { \
    const u16* ar_ = (base) + (wm * 32 + l31) * LDB + hi * 8 + (s) * 16; \
    const u16* br_ = (base) + 64 * LDB + (wn * 64 + l31) * LDB + hi * 8 + (s) * 16; \
    const bf16x8 a = *(const bf16x8*)(ar_), b0 = *(const bf16x8*)(br_), b1 = *(const bf16x8*)(br_ + 32 * LDB); \
    acc[0] = MFMA32(a, b0, acc[0]); acc[1] = MFMA32(a, b1, acc[1]); } while (0)
  GLOAD(0);
  __syncthreads();
  LWRITE(S0);
  GLOAD(64);
  __syncthreads();
#pragma unroll 1
  for (int kt = 0; kt < 16; ++kt) {
    u16* cur = S0 + (kt & 1) * STAGE;
    u16* nxt = S0 + ((kt & 1) ^ 1) * STAGE;
    COMPUTE(cur, 0);
    COMPUTE(cur, 1);
    if (kt + 1 < 16) LWRITE(nxt);
    if (kt + 2 < 16) GLOAD((kt + 2) * 64);
    COMPUTE(cur, 2);
    COMPUTE(cur, 3);
    __syncthreads();
  }
#undef GLOAD
#undef LWRITE
#undef COMPUTE
}

DI void stage_big(const f32x16 (&a)[2], float* Cs, int tid) {
  const int lane = tid & 63, wave = tid >> 6, wm = wave & 1, wn = wave >> 1, l31 = lane & 31, hi = lane >> 5;
#pragma unroll
  for (int ni = 0; ni < 2; ++ni)
#pragma unroll
    for (int r = 0; r < 16; ++r)
      Cs[(wm * 32 + (r & 3) + 8 * (r >> 2) + 4 * hi) * CSB + wn * 64 + ni * 32 + l31] = a[ni][r];
}
DI void stage_small(const f32x16& a, float* Cs, int tid) {
  const int lane = tid & 63, wave = tid >> 6, wm = wave & 1, wn = wave >> 1, l31 = lane & 31, hi = lane >> 5;
#pragma unroll
  for (int r = 0; r < 16; ++r)
    Cs[(wm * 32 + (r & 3) + 8 * (r >> 2) + 4 * hi) * CSS + wn * 32 + l31] = a[r];
}
struct Slab { const float* Cs; int cst; int m0, rstride, roff; };
DI int slab_tok(const Slab& S, int row) { return S.m0 + (row >> 5) * S.rstride + S.roff + (row & 31); }

DI bool big_tile_coords(int bid, int nb, int round, int NTb, int& mt, int& nt) {
  if (nb != 256) {
    const int t = bid + round * nb;
    if (t >= 128 * NTb) return false;
    mt = t / NTb; nt = t % NTb;
    return true;
  }
  const int x = bid & 7, q = (bid >> 3) + 32 * round;
  if (q >= 16 * NTb) return false;
  const int grp = q / (4 * NTb), qq = q - grp * 4 * NTb;
  const int c = qq >> 5, r = qq & 31;
  const int w = min(8, NTb - c * 8);
  mt = x * 16 + grp * 4 + r / w; nt = c * 8 + r % w;
  return true;
}

struct EvenOut { u16* P; u16* KB; u16* VT; u16* KI; float* WI; float* out; int e; };
DI void epi_even(const Slab& S, int t, const EvenOut& E, int tid) {
  const bool smp = S.m0 >= NTOK_P;
  const int e = E.e;
  if (t == 2) {
#pragma unroll 2
    for (int i = 0; i < 4; ++i) {
      const int idx = tid + NTHREADS * i, row = idx >> 5, c = (idx & 31) * 4;
      const int tok = slab_tok(S, row);
      const float4 kq = *(const float4*)(S.Cs + row * S.cst + c), vq = *(const float4*)(S.Cs + row * S.cst + 128 + c);
      const size_t ok = !smp ? O_KP + ((size_t)e * NTOK_P + tok) * 128 + c : O_KS + ((size_t)e * NTOK_S + (tok - NTOK_P)) * 128 + c;
      const size_t ov = !smp ? O_VP + ((size_t)e * NTOK_P + tok) * 128 + c : O_VS + ((size_t)e * NTOK_S + (tok - NTOK_P)) * 128 + c;
      *(float4*)(E.out + ok) = kq;
      *(float4*)(E.out + ov) = vq;
      uint2 pk; pk.x = pack2(kq.x, kq.y); pk.y = pack2(kq.z, kq.w);
      *(uint2*)(E.KB + (size_t)key_row(tok) * 128 + c) = pk;
    }
#pragma unroll
    for (int i = 0; i < 2; ++i) {
      const int idx = tid + NTHREADS * i, c = idx & 127, rg = idx >> 7;
      const int tok = slab_tok(S, rg * 8);
      const float* cp = S.Cs + (rg * 8) * S.cst + 128 + c;
      const int cs = S.cst;
      uint4 pk;
      pk.x = pack2(cp[0], cp[cs]); pk.y = pack2(cp[2 * cs], cp[3 * cs]); pk.z = pack2(cp[4 * cs], cp[5 * cs]); pk.w = pack2(cp[6 * cs], cp[7 * cs]);
      size_t vo;
      if (!smp) vo = (size_t)(tok >> 11) * 128 * 2048 + (size_t)c * 2048 + (tok & 2047);
      else vo = (size_t)NTOK_P * 128 + (size_t)((tok - NTOK_P) >> 6) * 128 * 1088 + (size_t)c * 1088 + 1024 + ((tok - NTOK_P) & 63);
      *(uint4*)(E.VT + vo) = pk;
    }
  } else if (t == 7) {
#pragma unroll 2
    for (int i = 0; i < 4; ++i) {
      const int idx = tid + NTHREADS * i, row = idx >> 5, c = (idx & 31) * 4;
      const int tok = slab_tok(S, row);
      const float4 v = *(const float4*)(S.Cs + row * S.cst + c);
      if (c < 64) {
        const size_t oo = !smp ? O_KIP + ((size_t)e * NTOK_P + tok) * 64 + c : O_KIS + ((size_t)e * NTOK_S + (tok - NTOK_P)) * 64 + c;
        *(float4*)(E.out + oo) = v;
        uint2 pk; pk.x = pack2(v.x, v.y); pk.y = pack2(v.z, v.w);
        *(uint2*)(E.KI + (size_t)key_row(tok) * 64 + c) = pk;
      } else if (c < 72) {
        *(float4*)(E.WI + (size_t)tok * 8 + (c - 64)) = v;
      }
    }
  } else if (t >= 8) {
    const bool isz = t < 12;
    const int pc = isz ? C_Z + (t - 8) * 128 : C_GBZ + (t - 12) * 128;
#pragma unroll 2
    for (int i = 0; i < 4; ++i) {
      const int idx = tid + NTHREADS * i, row = idx >> 5, c = (idx & 31) * 4;
      const int tok = slab_tok(S, row);
      const float4 a = *(const float4*)(S.Cs + row * S.cst + c), b2 = *(const float4*)(S.Cs + row * S.cst + 128 + c);
      float4 r;
      if (isz) { r.x = a.x * b2.x; r.y = a.y * b2.y; r.z = a.z * b2.z; r.w = a.w * b2.w; }
      else { r.x = a.x * silu_f(b2.x); r.y = a.y * silu_f(b2.y); r.z = a.z * silu_f(b2.z); r.w = a.w * silu_f(b2.w); }
      uint2 pk; pk.x = pack2(r.x, r.y); pk.y = pack2(r.z, r.w);
      *(uint2*)(E.P + (size_t)tok * PSE + pc + c) = pk;
      if (isz) {
        const int pos = smp ? (tok - NTOK_P) & 63 : tok & 2047;
        const int last = smp ? 62 : 2046;
        if (pos >= last) {
          float* o = smp ? E.out + O_CVS + (((size_t)e * 8 + ((tok - NTOK_P) >> 6)) * 2 + (pos - last)) * 512
                         : E.out + O_CVP + (((size_t)e * 16 + (tok >> 11)) * 2 + (pos - last)) * 512;
          *(float4*)(o + (t - 8) * 128 + c) = r;
        }
      }
    }
  } else {
    const int pc = t < 2 ? C_Q + t * 256 : (t < 5 ? C_GA + (t - 3) * 256 : C_QI + (t - 5) * 256);
#pragma unroll 2
    for (int i = 0; i < 4; ++i) {
      const int idx = tid + NTHREADS * i, row = idx >> 5, c = (idx & 31) * 4;
      const int tok = slab_tok(S, row);
      float4 a = *(const float4*)(S.Cs + row * S.cst + c), b2 = *(const float4*)(S.Cs + row * S.cst + 128 + c);
      if (t < 2) {
        const float qs = 0.18033688011112042f;
        a.x *= qs; a.y *= qs; a.z *= qs; a.w *= qs; b2.x *= qs; b2.y *= qs; b2.z *= qs; b2.w *= qs;
      } else if (t < 5) {
        a.x = silu_f(a.x); a.y = silu_f(a.y); a.z = silu_f(a.z); a.w = silu_f(a.w);
        b2.x = silu_f(b2.x); b2.y = silu_f(b2.y); b2.z = silu_f(b2.z); b2.w = silu_f(b2.w);
      }
      uint2 pa, pb; pa.x = pack2(a.x, a.y); pa.y = pack2(a.z, a.w); pb.x = pack2(b2.x, b2.y); pb.y = pack2(b2.z, b2.w);
      *(uint2*)(E.P + (size_t)tok * PSE + pc + c) = pa;
      *(uint2*)(E.P + (size_t)tok * PSE + pc + 128 + c) = pb;
    }
  }
}

DI void phase_gemm_even_in(const PV& p, Blk B, int e, unsigned char* lds, int tid) {
  const u16* H = (const u16*)(p.wsp() + WS_H);
  const u16* W = (const u16*)(p.wsp() + WS_WEIN) + (size_t)e * WE_ROWS * 1024;
  EvenOut E;
  E.P = (u16*)(p.wsp() + WS_P);
  E.KB = (u16*)(p.wsp() + WS_KB) + (size_t)e * KROWS * 128;
  E.VT = (u16*)(p.wsp() + WS_VT) + (size_t)e * KROWS * 128;
  E.KI = (u16*)(p.wsp() + WS_KI) + (size_t)e * KROWS * 64;
  E.WI = (float*)(p.wsp() + WS_WI);
  E.out = p.outp(); E.e = e;
  float* Cs = (float*)lds;
  for (int round = 0;; ++round) {
    int mt, nt;
    if (!big_tile_coords(B.bid, B.nb, round, 16, mt, nt)) break;
    f32x16 acc[4][2];
    gemm_big(H, W, mt * 256, nt * 256, lds, acc, tid);
#pragma unroll
    for (int mi = 0; mi < 4; ++mi) {
      float* Cb = Cs + (mi & 1) * (64 * CSB);
      stage_big(acc[mi], Cb, tid);
      __syncthreads();
      Slab S; S.Cs = Cb; S.cst = CSB; S.m0 = mt * 256; S.rstride = 128; S.roff = mi * 32;
      epi_even(S, nt, E, tid);
    }
  }
  for (int t = B.bid; t < 8 * 16; t += B.nb) {
    const int ms = t >> 4, nt = t & 15;
    f32x16 acc[2];
    gemm_small(H, W, NTOK_P + ms * 64, nt * 256, lds, acc, tid);
    stage_big(acc, Cs, tid);
    __syncthreads();
    Slab S; S.Cs = Cs; S.cst = CSB; S.m0 = NTOK_P + ms * 64; S.rstride = 32; S.roff = 0;
    epi_even(S, nt, E, tid);
    __syncthreads();
  }
}

DI void epi_odd(const Slab& S, int t, u16* P, int tid) {
#pragma unroll 2
  for (int i = 0; i < 4; ++i) {
    const int idx = tid + NTHREADS * i, row = idx >> 5, c = (idx & 31) * 4;
    const int tok = slab_tok(S, row);
    const float4 a = *(const float4*)(S.Cs + row * S.cst + c), b2 = *(const float4*)(S.Cs + row * S.cst + 128 + c);
    if (t < 8) {
      float4 r;
      r.x = gelu_f(a.x) * silu_f(b2.x); r.y = gelu_f(a.y) * silu_f(b2.y); r.z = gelu_f(a.z) * silu_f(b2.z); r.w = gelu_f(a.w) * silu_f(b2.w);
      uint2 pk; pk.x = pack2(r.x, r.y); pk.y = pack2(r.z, r.w);
      *(uint2*)(P + (size_t)tok * PSO + t * 128 + c) = pk;
    } else {
      uint2 pa, pb;
      pa.x = pack2(gelu_f(a.x), gelu_f(a.y)); pa.y = pack2(gelu_f(a.z), gelu_f(a.w));
      pb.x = pack2(gelu_f(b2.x), gelu_f(b2.y)); pb.y = pack2(gelu_f(b2.z), gelu_f(b2.w));
      *(uint2*)(P + (size_t)tok * PSO + 1024 + (t - 8) * 256 + c) = pa;
      *(uint2*)(P + (size_t)tok * PSO + 1024 + (t - 8) * 256 + 128 + c) = pb;
    }
  }
}
DI void phase_gemm_odd_in(const PV& p, Blk B, int o, unsigned char* lds, int tid) {
  const u16* H = (const u16*)(p.wsp() + WS_H);
  const u16* W = (const u16*)(p.wsp() + WS_WOIN) + (size_t)o * WO_ROWS * 1024;
  u16* P = (u16*)(p.wsp() + WS_P);
  float* Cs = (float*)lds;
  for (int round = 0;; ++round) {
    int mt, nt;
    if (!big_tile_coords(B.bid, B.nb, round, 12, mt, nt)) break;
    f32x16 acc[4][2];
    gemm_big(H, W, mt * 256, nt * 256, lds, acc, tid);
#pragma unroll
    for (int mi = 0; mi < 4; ++mi) {
      float* Cb = Cs + (mi & 1) * (64 * CSB);
      stage_big(acc[mi], Cb, tid);
      __syncthreads();
      Slab S; S.Cs = Cb; S.cst = CSB; S.m0 = mt * 256; S.rstride = 128; S.roff = mi * 32;
      epi_odd(S, nt, P, tid);
    }
  }
  for (int t = B.bid; t < 8 * 12; t += B.nb) {
    const int ms = t / 12, nt = t - ms * 12;
    f32x16 acc[2];
    gemm_small(H, W, NTOK_P + ms * 64, nt * 256, lds, acc, tid);
    stage_big(acc, Cs, tid);
    __syncthreads();
    Slab S; S.Cs = Cs; S.cst = CSB; S.m0 = NTOK_P + ms * 64; S.rstride = 32; S.roff = 0;
    epi_odd(S, nt, P, tid);
    __syncthreads();
  }
}

struct OutArgs { const float* modl; const float* xp; const float* xs; float* X; int layer; };
DI void epi_out(const Slab& S, int coff, int n0s, const OutArgs& O, int tid_in) {
  int tid = tid_in;
  asm volatile("" : "+v"(tid));
  float4 xv[4], gv[4];
#pragma unroll
  for (int i = 0; i < 4; ++i) {
    const int idx = tid + NTHREADS * i, row = idx >> 5, c = (idx & 31) * 4;
    const int tok = slab_tok(S, row);
    const float* xr = O.layer == 0 ? (tok < NTOK_P ? O.xp + (size_t)tok * 1024 : O.xs + (size_t)(tok - NTOK_P) * 1024) : O.X + (size_t)tok * 1024;
    xv[i] = *(const float4*)(xr + n0s + c);
    gv[i] = *(const float4*)(O.modl + (size_t)mod_row(tok) * 3072 + 2048 + n0s + c);
  }
#pragma unroll
  for (int i = 0; i < 4; ++i) {
    const int idx = tid + NTHREADS * i, row = idx >> 5, c = (idx & 31) * 4;
    const int tok = slab_tok(S, row);
    const float4 v = *(const float4*)(S.Cs + row * S.cst + coff + c);
    float4 x = xv[i];
    x.x += gv[i].x * v.x; x.y += gv[i].y * v.y; x.z += gv[i].z * v.z; x.w += gv[i].w * v.w;
    *(float4*)(O.X + (size_t)tok * 1024 + n0s + c) = x;
  }
}
DI void phase_gemm_out(const PV& p, Blk B, int layer, unsigned char* lds, int tid) {
  const u16* A = (const u16*)(p.wsp() + WS_H);
  const u16* W = (layer & 1) ? (const u16*)(p.wsp() + WS_WOOUT) + (size_t)(layer >> 1) * 1024 * 1024
                             : (const u16*)(p.wsp() + WS_WEOUT) + (size_t)(layer >> 1) * 1024 * 1024;
  OutArgs O;
  O.modl = (const float*)(p.wsp() + WS_MOD) + (size_t)layer * 24 * 3072;
  O.xp = p.inp(I_XP); O.xs = p.inp(I_XS); O.X = p.outp(); O.layer = layer;
  float* Cs = (float*)lds;
  for (int round = 0;; ++round) {
    int mt, nt;
    if (!big_tile_coords(B.bid, B.nb, round, 4, mt, nt)) break;
    f32x16 acc[4][2];
    gemm_big(A, W, mt * 256, nt * 256, lds, acc, tid);
    {
      int tid_e = tid;
      asm volatile("" : "+v"(tid_e));
      const int c = (tid_e & 31) * 4, r0 = tid_e >> 5;
      const float* xsrc = layer == 0 ? p.inp(I_XP) : O.X;
      const float* grow = O.modl + (size_t)mod_row(mt * 256) * 3072 + 2048 + nt * 256 + c;
      const float4 g0 = *(const float4*)grow, g1 = *(const float4*)(grow + 128);
#pragma unroll
      for (int mi = 0; mi < 4; ++mi) {
        float* Cb = Cs + (mi & 1) * (64 * CSB);
        float4 xv[4][2];
#pragma unroll
        for (int i = 0; i < 4; ++i) {
          const int row = r0 + 16 * i;
          const size_t off = (size_t)(mt * 256 + (row >> 5) * 128 + mi * 32 + (row & 31)) * 1024 + nt * 256 + c;
          xv[i][0] = *(const float4*)(xsrc + off); xv[i][1] = *(const float4*)(xsrc + off + 128);
        }
        stage_big(acc[mi], Cb, tid);
        __syncthreads();
#pragma unroll
        for (int i = 0; i < 4; ++i) {
          const int row = r0 + 16 * i;
          const size_t off = (size_t)(mt * 256 + (row >> 5) * 128 + mi * 32 + (row & 31)) * 1024 + nt * 256 + c;
          const float4 v0 = *(const float4*)(Cb + row * CSB + c), v1 = *(const float4*)(Cb + row * CSB + 128 + c);
          float4 x0 = xv[i][0], x1 = xv[i][1];
          x0.x += g0.x * v0.x; x0.y += g0.y * v0.y; x0.z += g0.z * v0.z; x0.w += g0.w * v0.w;
          x1.x += g1.x * v1.x; x1.y += g1.y * v1.y; x1.z += g1.z * v1.z; x1.w += g1.w * v1.w;
          *(float4*)(O.X + off) = x0; *(float4*)(O.X + off + 128) = x1;
        }
      }
    }
  }
  for (int t = B.bid; t < 8 * 4; t += B.nb) {
    const int ms = t >> 2, nt = t & 3;
    f32x16 acc[2];
    gemm_small(A, W, NTOK_P + ms * 64, nt * 256, lds, acc, tid);
    stage_big(acc, Cs, tid);
    __syncthreads();
    Slab S; S.Cs = Cs; S.cst = CSB; S.m0 = NTOK_P + ms * 64; S.rstride = 32; S.roff = 0;
    epi_out(S, 0, nt * 256, O, tid);
    epi_out(S, 128, nt * 256 + 128, O, tid);
    __syncthreads();
  }
}

constexpr int MSTR = 33;
template <int NREG>
DI void emit_mask(const unsigned (&kv)[NREG], unsigned T, u64* __restrict__ mrow, int nkt, int lane) {
  int cgt = 0;
#pragma unroll
  for (int i = 0; i < NREG; ++i) cgt += __popcll(__ballot(kv[i] > T));
  const int need = 256 - cgt;
  int run = 0;
  const u64 below = (1ull << lane) - 1ull;
  unsigned T2 = __builtin_amdgcn_readfirstlane(T);
  asm volatile("" : "+s"(T2));
#pragma unroll
  for (int i = 0; i < NREG; ++i) {
    if (i < nkt) {
      const u64 eq = __ballot(kv[i] == T2), gtm = __ballot(kv[i] > T2);
      const int pre = __popcll(eq & below);
      const bool se = (kv[i] == T2) && (run + pre < need);
      const u64 sel = gtm | __ballot(se);
      run += __popcll(eq);
      if (lane == 0) mrow[i] = sel;
    }
  }
}
template <int NREG>
DI void select_pair(const u16* __restrict__ sA, const u16* __restrict__ sB, u64* __restrict__ mrowA, u64* __restrict__ mrowB, int nkt, int lane) {
  unsigned ka[NREG], kb[NREG];
#pragma unroll
  for (int i = 0; i < NREG; ++i) {
    unsigned ua = 0, ub = 0;
    if (i < nkt) { ua = sA[i * 64 + lane]; ub = sB[i * 64 + lane]; }
    ka[i] = i < nkt ? ((ua & 0x8000u) ? (~ua & 0xffffu) : (ua | 0x8000u)) : 0u;
    kb[i] = i < nkt ? ((ub & 0x8000u) ? (~ub & 0xffffu) : (ub | 0x8000u)) : 0u;
  }
  unsigned TA = 0, TB = 0;
  for (int bit = 15; bit >= 0; --bit) {
    const unsigned ca = TA | (1u << bit), cb = TB | (1u << bit);
    int na = 0, nb2 = 0;
#pragma unroll
    for (int i = 0; i < NREG; ++i) { na += __popcll(__ballot(ka[i] >= ca)); nb2 += __popcll(__ballot(kb[i] >= cb)); }
    if (na >= 256) TA = ca;
    if (nb2 >= 256) TB = cb;
  }
  emit_mask<NREG>(ka, TA, mrowA, nkt, lane);
  emit_mask<NREG>(kb, TB, mrowB, nkt, lane);
}
template <int NREG>
DI void select_item(const u16* __restrict__ SC, u64* __restrict__ MASK, int wave, int nkt, int lane) {
#pragma unroll 1
  for (int qp = 0; qp < 4; ++qp) {
    const int q = wave * 8 + qp * 2;
    select_pair<NREG>(SC + (size_t)q * 2048, SC + (size_t)(q + 1) * 2048, MASK + q * MSTR, MASK + (q + 1) * MSTR, nkt, lane);
  }
}

constexpr int KSTR = 136;
constexpr int VTSTR = 68;
DI void phase_attn(const PV& p, Blk B, int e, unsigned char* lds, int tid) {
  const int lane = tid & 63, wave = tid >> 6, l31 = lane & 31, hi = lane >> 5;
  const u16* P = (const u16*)(p.wsp() + WS_P);
  const u16* KBe = (const u16*)(p.wsp() + WS_KB) + (size_t)e * KROWS * 128;
  const u16* VTe = (const u16*)(p.wsp() + WS_VT) + (size_t)e * KROWS * 128;
  const u16* KIe = (const u16*)(p.wsp() + WS_KI) + (size_t)e * KROWS * 64;
  const float* WI = (const float*)(p.wsp() + WS_WI);
  u16* AB = (u16*)(p.wsp() + WS_H);
  u16* SC = (u16*)(p.wsp() + WS_SC) + (size_t)B.bid * 64 * 2048;
  u64* MASK = (u64*)lds;
  float* out = p.outp();
  constexpr int NITEMS = 520;
  unsigned* qctr = (unsigned*)(p.wsp() + WS_CTR) + e;
  int* itw = (int*)(lds + LDS_BYTES - 16);
  for (;;) {
    __syncthreads();
    if (tid == 0) *itw = (int)atomicAdd(qctr, 1u);
    __syncthreads();
    const int it = *itw;
    if (it >= NITEMS) break;
    int seq, tok0, nkt, Lseq; size_t kbase, vbase;
    bool is_s;
    if (it >= 240 && it < 248) {
      const int si = it - 240;
      is_s = true; seq = 16 + si; tok0 = NTOK_P + si * 64; nkt = 17; Lseq = 1088;
      kbase = (size_t)NTOK_P + (size_t)si * 1088; vbase = (size_t)NTOK_P * 128 + (size_t)si * 128 * 1088;
    } else {
      is_s = false; const int k = it < 240 ? it : it - 8; const int c = 31 - (k >> 4); seq = k & 15; tok0 = seq * 2048 + c * 64; nkt = c + 1; Lseq = 2048;
      kbase = (size_t)seq * 2048; vbase = (size_t)seq * 128 * 2048;
    }
    const int Nk = nkt * 64;

    for (int rep_ = 0; rep_ < ((ATT_REP & 8) ? 2 : 1); ++rep_) {
      const int c = lane * 8;
      const float* cw = p.inp(I_EVCONV) + (size_t)e * 3 * 512 + c;
      float w0[8], w1[8], w2[8], z1[8] = {0.f, 0.f, 0.f, 0.f, 0.f, 0.f, 0.f, 0.f}, z2[8] = {0.f, 0.f, 0.f, 0.f, 0.f, 0.f, 0.f, 0.f};
      {
        const float4 a0 = *(const float4*)cw, a1 = *(const float4*)(cw + 4), b0 = *(const float4*)(cw + 512), b1 = *(const float4*)(cw + 516),
                     c0 = *(const float4*)(cw + 1024), c1 = *(const float4*)(cw + 1028);
        w0[0] = a0.x; w0[1] = a0.y; w0[2] = a0.z; w0[3] = a0.w; w0[4] = a1.x; w0[5] = a1.y; w0[6] = a1.z; w0[7] = a1.w;
        w1[0] = b0.x; w1[1] = b0.y; w1[2] = b0.z; w1[3] = b0.w; w1[4] = b1.x; w1[5] = b1.y; w1[6] = b1.z; w1[7] = b1.w;
        w2[0] = c0.x; w2[1] = c0.y; w2[2] = c0.z; w2[3] = c0.w; w2[4] = c1.x; w2[5] = c1.y; w2[6] = c1.z; w2[7] = c1.w;
      }
      const int tl0 = wave * 8;
      uint4 zq[10], gq[8];
      const bool halo_mem = tl0 > 0 || (!is_s && (tok0 & 2047) != 0);
#pragma unroll
      for (int r = 0; r < 10; ++r) {
        const int tl = tl0 + r - 2;
        const int tls = (r < 2 && !halo_mem) ? 0 : tl;
        zq[r] = *(const uint4*)(P + (size_t)(tok0 + tls) * PSE + C_Z + c);
      }
#pragma unroll
      for (int r = 0; r < 8; ++r) gq[r] = *(const uint4*)(P + (size_t)(tok0 + tl0 + r) * PSE + C_GBZ + c);
      float4 h0a = make_float4(0.f, 0.f, 0.f, 0.f), h0b = h0a, h1a = h0a, h1b = h0a;
      if (!halo_mem && is_s) {
        const float* hs = p.inp(I_SCONV) + ((size_t)e * 8 + (seq - 16)) * 2 * 512 + c;
        h0a = *(const float4*)hs; h0b = *(const float4*)(hs + 4); h1a = *(const float4*)(hs + 512); h1b = *(const float4*)(hs + 516);
      }
#pragma unroll
      for (int r = 0; r < 10; ++r) {
        float z[8];
        if (r < 2 && !halo_mem) {
          const float4 a = r == 0 ? h0a : h1a, b2 = r == 0 ? h0b : h1b;
          z[0] = a.x; z[1] = a.y; z[2] = a.z; z[3] = a.w; z[4] = b2.x; z[5] = b2.y; z[6] = b2.z; z[7] = b2.w;
        } else {
          const unsigned zw[4] = {zq[r].x, zq[r].y, zq[r].z, zq[r].w};
#pragma unroll
          for (int i = 0; i < 4; ++i) { z[2 * i] = bf2f((u16)(zw[i] & 0xffff)); z[2 * i + 1] = bf2f((u16)(zw[i] >> 16)); }
        }
        if (r >= 2) {
          const unsigned bw[4] = {gq[r - 2].x, gq[r - 2].y, gq[r - 2].z, gq[r - 2].w};
          float y[8];
#pragma unroll
          for (int i = 0; i < 8; ++i) y[i] = w2[i] * z[i] + w1[i] * z1[i] + w0[i] * z2[i];
          unsigned ow[4];
#pragma unroll
          for (int i = 0; i < 4; ++i) ow[i] = pack2(bf2f((u16)(bw[i] & 0xffff)) * y[2 * i], bf2f((u16)(bw[i] >> 16)) * y[2 * i + 1]);
          uint4 ov; ov.x = ow[0]; ov.y = ow[1]; ov.z = ow[2]; ov.w = ow[3];
          *(uint4*)(AB + (size_t)(tok0 + tl0 + r - 2) * 1024 + 512 + c) = ov;
        }
#pragma unroll
        for (int i = 0; i < 8; ++i) { z2[i] = z1[i]; z1[i] = z[i]; }
      }
    }

    for (int rep_ = 0; rep_ < ((ATT_REP & 1) ? 2 : 1); ++rep_)
    if (Nk > 256) {
      const int qb = wave & 3, kp = wave >> 2;
      int lane_a = lane;
      asm volatile("" : "+v"(lane_a));
      const int l15 = lane_a & 15, l4 = lane_a >> 4;
      const int qtok = tok0 + qb * 16 + l15;
      bf16x8 bq[8][2];
      float wi[8];
#pragma unroll
      for (int h = 0; h < 8; ++h) {
        bq[h][0] = *(const bf16x8*)(P + (size_t)qtok * PSE + C_QI + h * 64 + l4 * 8);
        bq[h][1] = *(const bf16x8*)(P + (size_t)qtok * PSE + C_QI + h * 64 + 32 + l4 * 8);
        wi[h] = WI[(size_t)qtok * 8 + h];
      }
      const int ntl = (nkt - kp + 1) >> 1;
      const u16* kr0 = KIe + (kbase + l15) * 64 + l4 * 8;
      bf16x8 ca[4][2];
#pragma unroll
      for (int kb = 0; kb < 4; ++kb) {
        ca[kb][0] = *(const bf16x8*)(kr0 + (size_t)(kp * 64 + kb * 16) * 64);
        ca[kb][1] = *(const bf16x8*)(kr0 + (size_t)(kp * 64 + kb * 16) * 64 + 32);
      }
#pragma unroll 1
      for (int tl = 0; tl < ntl; ++tl) {
        const int kt = kp + 2 * tl;
        const int ktn = tl + 1 < ntl ? kt + 2 : kt;
#pragma unroll
        for (int kb = 0; kb < 4; ++kb) {
          float s0 = 0.f, s1 = 0.f, s2 = 0.f, s3 = 0.f;
#pragma unroll
          for (int h = 0; h < 8; ++h) {
            f32x4 c = {0.f, 0.f, 0.f, 0.f};
            c = MFMA16(ca[kb][0], bq[h][0], c);
            c = MFMA16(ca[kb][1], bq[h][1], c);
            s0 += wi[h] * fmaxf(c[0], 0.f); s1 += wi[h] * fmaxf(c[1], 0.f);
            s2 += wi[h] * fmaxf(c[2], 0.f); s3 += wi[h] * fmaxf(c[3], 0.f);
          }
          ca[kb][0] = *(const bf16x8*)(kr0 + (size_t)(ktn * 64 + kb * 16) * 64);
          ca[kb][1] = *(const bf16x8*)(kr0 + (size_t)(ktn * 64 + kb * 16) * 64 + 32);
          const _Float16 h0 = (_Float16)s0, h1 = (_Float16)s1, h2 = (_Float16)s2, h3 = (_Float16)s3;
          uint2 pk;
          pk.x = (unsigned)__builtin_bit_cast(u16, h0) | ((unsigned)__builtin_bit_cast(u16, h1) << 16);
          pk.y = (unsigned)__builtin_bit_cast(u16, h2) | ((unsigned)__builtin_bit_cast(u16, h3) << 16);
          *(uint2*)(SC + (size_t)(qb * 16 + l15) * 2048 + kt * 64 + kb * 16 + l4 * 4) = pk;
          __builtin_amdgcn_sched_barrier(0);
        }
      }
    }
    __syncthreads();

    for (int rep_ = 0; rep_ < ((ATT_REP & 2) ? 2 : 1); ++rep_) {
      if (Nk <= 256) {
        for (int qi = 0; qi < 8; ++qi) if (lane < nkt) MASK[(wave * 8 + qi) * MSTR + lane] = ~0ull;
      } else if (nkt <= 8) select_item<8>(SC, MASK, wave, nkt, lane);
      else if (nkt <= 16) select_item<16>(SC, MASK, wave, nkt, lane);
      else if (nkt <= 24) select_item<24>(SC, MASK, wave, nkt, lane);
      else select_item<32>(SC, MASK, wave, nkt, lane);
    }
    __syncthreads();

    for (int rep_ = 0; rep_ < ((ATT_REP & 4) ? 2 : 1); ++rep_) {
      int tid_c = tid;
      asm volatile("" : "+v"(tid_c));
      const int l31 = tid_c & 31, hi = (tid_c >> 5) & 1;
      const int qh = wave & 1, hp = wave >> 1, g = hp >> 1;
      const int qtok = tok0 + qh * 32 + l31;
      u16* Ks = (u16*)(lds + 64 * MSTR * 8);
      u16* Vs = Ks + 64 * KSTR;
      const int kr_ = tid_c >> 4, kc_ = (tid_c & 15) * 8;
      const int vr_ = tid_c >> 3, vc_ = (tid_c & 7) * 8;
      const u16* kg = KBe + (kbase + kr_) * 128 + kc_;
      const u16* vg = VTe + vbase + (size_t)vr_ * Lseq + vc_;
      const unsigned* mq = (const unsigned*)(MASK + (qh * 32 + l31) * MSTR);
      const u16* ksr = Ks + l31 * KSTR + g * 64 + hi * 8;
      const u16* vsr = Vs + (g * 64 + l31) * VTSTR + hi * 4;
      uint4 ak0 = *(const uint4*)kg, ak1 = *(const uint4*)(kg + 32 * 128);
      uint4 av0 = *(const uint4*)vg, av1 = *(const uint4*)(vg + (size_t)64 * Lseq);
      bf16x8 qf[2][4];
#pragma unroll
      for (int j = 0; j < 2; ++j)
#pragma unroll
        for (int s = 0; s < 4; ++s) qf[j][s] = *(const bf16x8*)(P + (size_t)qtok * PSE + C_Q + (hp * 2 + j) * 64 + s * 16 + hi * 8);
      f32x16 o[2][2];
#pragma unroll
      for (int j = 0; j < 2; ++j)
#pragma unroll
        for (int db = 0; db < 2; ++db)
#pragma unroll
          for (int r = 0; r < 16; ++r) o[j][db][r] = 0.f;
      float l_[2] = {0.f, 0.f};
#pragma unroll 1
      for (int kt = 0; kt < nkt; ++kt) {
        __syncthreads();
        *(uint4*)(Ks + kr_ * KSTR + kc_) = ak0; *(uint4*)(Ks + (kr_ + 32) * KSTR + kc_) = ak1;
        *(uint2*)(Vs + vr_ * VTSTR + vc_) = make_uint2(av0.x, av0.y); *(uint2*)(Vs + vr_ * VTSTR + vc_ + 4) = make_uint2(av0.z, av0.w);
        *(uint2*)(Vs + (vr_ + 64) * VTSTR + vc_) = make_uint2(av1.x, av1.y); *(uint2*)(Vs + (vr_ + 64) * VTSTR + vc_ + 4) = make_uint2(av1.z, av1.w);
        __syncthreads();
        if (kt + 1 < nkt) {
          const u16* kg2 = kg + (size_t)(kt + 1) * 64 * 128;
          const u16* vg2 = vg + (kt + 1) * 64;
          ak0 = *(const uint4*)kg2; ak1 = *(const uint4*)(kg2 + 32 * 128);
          av0 = *(const uint4*)vg2; av1 = *(const uint4*)(vg2 + (size_t)64 * Lseq);
        }
#pragma unroll
        for (int kb2 = 0; kb2 < 2; ++kb2) {
          bf16x8 kf[4];
#pragma unroll
          for (int s = 0; s < 4; ++s) kf[s] = *(const bf16x8*)(ksr + kb2 * 32 * KSTR + s * 16);
          bf16x8 vf[2][2];
#pragma unroll
          for (int db = 0; db < 2; ++db)
#pragma unroll
            for (int s2 = 0; s2 < 2; ++s2) {
              const u16* vp = vsr + db * 32 * VTSTR + kb2 * 32 + s2 * 16;
              const uint2 lo = *(const uint2*)vp, hh2 = *(const uint2*)(vp + 8);
              uint4 u; u.x = lo.x; u.y = lo.y; u.z = hh2.x; u.w = hh2.y;
              vf[db][s2] = __builtin_bit_cast(bf16x8, u);
            }
          const unsigned mb = mq[kt * 2 + kb2] >> (4 * hi);
#pragma unroll
          for (int j = 0; j < 2; ++j) {
            f32x16 st;
#pragma unroll
            for (int r = 0; r < 16; ++r) st[r] = 0.f;
#pragma unroll
            for (int s = 0; s < 4; ++s) st = MFMA32(kf[s], qf[j][s], st);
            float ps = 0.f;
#pragma unroll
            for (int r = 0; r < 16; ++r) {
              const float ex = __builtin_amdgcn_exp2f(st[r]);
              const float pv = (mb & (1u << ((r & 3) + 8 * (r >> 2)))) ? ex : 0.f;
              st[r] = pv; ps += pv;
            }
            l_[j] += ps;
#pragma unroll
            for (int s2 = 0; s2 < 2; ++s2) {
              uint4 u;
              u.x = pack2(st[8 * s2 + 0], st[8 * s2 + 1]); u.y = pack2(st[8 * s2 + 2], st[8 * s2 + 3]);
              u.z = pack2(st[8 * s2 + 4], st[8 * s2 + 5]); u.w = pack2(st[8 * s2 + 6], st[8 * s2 + 7]);
              const bf16x8 pf = __builtin_bit_cast(bf16x8, u);
#pragma unroll
              for (int db = 0; db < 2; ++db) o[j][db] = MFMA32(vf[db][s2], pf, o[j][db]);
            }
            __builtin_amdgcn_sched_barrier(0);
          }
        }
      }
#pragma unroll
      for (int j = 0; j < 2; ++j) {
        const int hh = hp * 2 + j;
        const float lt = l_[j] + __shfl_xor(l_[j], 32);
        const float inv = 1.f / lt;
#pragma unroll
        for (int db = 0; db < 2; ++db)
#pragma unroll
          for (int rg = 0; rg < 4; ++rg) {
            const int col = hh * 64 + db * 32 + 8 * rg + 4 * hi;
            const uint2 gg = *(const uint2*)(P + (size_t)qtok * PSE + C_GA + col);
            const float g0 = bf2f((u16)(gg.x & 0xffff)), g1 = bf2f((u16)(gg.x >> 16)), g2 = bf2f((u16)(gg.y & 0xffff)), g3 = bf2f((u16)(gg.y >> 16));
            uint2 ov;
            ov.x = pack2(o[j][db][4 * rg + 0] * inv * g0, o[j][db][4 * rg + 1] * inv * g1);
            ov.y = pack2(o[j][db][4 * rg + 2] * inv * g2, o[j][db][4 * rg + 3] * inv * g3);
            *(uint2*)(AB + (size_t)qtok * 1024 + col) = ov;
          }
      }
    }
    __syncthreads();
  }
}

constexpr int VSTR = 136;
DI void phase_sgu(const PV& p, Blk B, int o, unsigned char* lds, int tid) {
  const int lane = tid & 63, wave = tid >> 6, l31 = lane & 31, hi = lane >> 5;
  const u16* P = (const u16*)(p.wsp() + WS_P);
  u16* Mo = (u16*)(p.wsp() + WS_H);
  const u16* WSB = (const u16*)(p.wsp() + WS_WSB) + (size_t)o * 8 * 128 * 128;
  const float* bs = p.inp(I_ODBS) + (size_t)o * 8 * 128;
  const float* lng = p.inp(I_ODLNG) + (size_t)o * 1024;
  const float* lnb = p.inp(I_ODLNB) + (size_t)o * 1024;
  float* out = p.outp();
  u16* vnT = (u16*)lds;
  float* MU = (float*)(lds + 128 * CST * 4);
  float* RS = MU + 128;
  float* LNG = RS + 128;
  for (int i = tid; i < 1024; i += NTHREADS) { LNG[i] = lng[i]; LNG[1024 + i] = lnb[i]; }
  constexpr int NITEMS = 256 + 64;
  for (int it = B.bid; it < NITEMS; it += B.nb) {
    const bool smp = it >= 256;
    const int si = smp ? (it - 256) >> 3 : 0;
    const int tokb = smp ? NTOK_P + si * 64 : it * 128;
    const int valid = smp ? 64 : 128;
    const int g_lo = smp ? (it - 256) & 7 : 0, g_hi = smp ? g_lo + 1 : 8;
#pragma unroll 1
    for (int half = 0; half < 4; ++half) {
      uint4 va[4], vb[4];
#pragma unroll
      for (int rr = 0; rr < 4; ++rr) {
        const int j = wave * 16 + half * 4 + rr;
        const u16* vr = P + (size_t)(tokb + (j < valid ? j : 0)) * PSO + 1024 + lane * 16;
        va[rr] = *(const uint4*)vr; vb[rr] = *(const uint4*)(vr + 8);
      }
#pragma unroll
      for (int rr = 0; rr < 4; ++rr) {
        const int j = wave * 16 + half * 4 + rr;
        const unsigned w[8] = {va[rr].x, va[rr].y, va[rr].z, va[rr].w, vb[rr].x, vb[rr].y, vb[rr].z, vb[rr].w};
        float sm = 0.f, s2 = 0.f;
#pragma unroll
        for (int i = 0; i < 8; ++i) {
          const float f0 = bf2f((u16)(w[i] & 0xffff)), f1 = bf2f((u16)(w[i] >> 16));
          sm += f0 + f1; s2 += f0 * f0 + f1 * f1;
        }
        sm = wave_sum(sm); s2 = wave_sum(s2);
        const float mu = sm * (1.f / 1024.f);
        const float var = fmaxf(s2 * (1.f / 1024.f) - mu * mu, 0.f);
        if (lane == 0 && j < valid) { MU[j] = mu; RS[j] = rsqrtf(var + 1e-6f); }
      }
    }
    __syncthreads();
    const int ib = wave & 3, ch = wave >> 2;
    const int ns = (ib + 1) * 2;
    int tid_g = tid;
    asm volatile("" : "+v"(tid_g));
    const int jb = tid_g >> 2, c0 = (tid_g & 3) * 32;
    const int l31 = tid_g & 31, hi = (tid_g >> 5) & 1;
    uint4 vr4[4];
    bf16x8 wa[8];
    uint2 uu[8];
    float bbv[8];
#define LOAD_V(gx) do { const u16* vr_ = P + (size_t)(tokb + (jb < valid ? jb : 0)) * PSO + 1024 + (gx) * 128 + c0; \
      _Pragma("unroll") for (int q = 0; q < 4; ++q) vr4[q] = *(const uint4*)(vr_ + q * 8); } while (0)
#define LOAD_W(gx) do { const u16* wr_ = WSB + ((size_t)(gx) * 128 + ib * 32 + l31) * 128 + hi * 8; \
      _Pragma("unroll") for (int s2 = 0; s2 < 8; ++s2) wa[s2] = *(const bf16x8*)(wr_ + (s2 < ns ? s2 : 0) * 16); } while (0)
#define LOAD_U(gx) do { _Pragma("unroll") for (int i2 = 0; i2 < 8; ++i2) { \
        const int idx_ = tid_g + NTHREADS * i2, row_ = idx_ >> 5, c_ = (idx_ & 31) * 4; \
        const int rr_ = row_ < valid ? row_ : 0; \
        uu[i2] = *(const uint2*)(P + (size_t)(tokb + rr_) * PSO + (gx) * 128 + c_);     \
        bbv[i2] = bs[(gx) * 128 + rr_]; } } while (0)
    LOAD_V(g_lo); LOAD_W(g_lo); LOAD_U(g_lo);
#pragma unroll 1
    for (int g = g_lo; g < g_hi; ++g) {
      if (jb < valid) {
        const float mu = MU[jb], rs = RS[jb];
#pragma unroll
        for (int q = 0; q < 4; ++q) {
          const unsigned w[4] = {vr4[q].x, vr4[q].y, vr4[q].z, vr4[q].w};
          const float4 ga = *(const float4*)(LNG + g * 128 + c0 + q * 8), gb2 = *(const float4*)(LNG + g * 128 + c0 + q * 8 + 4);
          const float4 ba = *(const float4*)(LNG + 1024 + g * 128 + c0 + q * 8), bb2 = *(const float4*)(LNG + 1024 + g * 128 + c0 + q * 8 + 4);
          const float gg[8] = {ga.x, ga.y, ga.z, ga.w, gb2.x, gb2.y, gb2.z, gb2.w};
          const float bbw[8] = {ba.x, ba.y, ba.z, ba.w, bb2.x, bb2.y, bb2.z, bb2.w};
          float f[8];
#pragma unroll
          for (int i = 0; i < 4; ++i) {
            f[2 * i] = (bf2f((u16)(w[i] & 0xffff)) - mu) * rs * gg[2 * i] + bbw[2 * i];
            f[2 * i + 1] = (bf2f((u16)(w[i] >> 16)) - mu) * rs * gg[2 * i + 1] + bbw[2 * i + 1];
          }
#pragma unroll
          for (int i = 0; i < 8; ++i) vnT[(c0 + q * 8 + i) * VSTR + jb] = f2bf(f[i]);
          if (smp) {
            float* oc = out + O_CV + (((size_t)o * 8 + si) * 64 + jb) * 1024 + g * 128 + c0 + q * 8;
            *(float4*)oc = make_float4(f[0], f[1], f[2], f[3]);
            *(float4*)(oc + 4) = make_float4(f[4], f[5], f[6], f[7]);
          }
        }
      } else {
#pragma unroll
        for (int c = 0; c < 32; ++c) vnT[(c0 + c) * VSTR + jb] = 0;
      }
      if (g + 1 < g_hi) LOAD_V(g + 1);
      __syncthreads();
      f32x16 acc[2];
#pragma unroll
      for (int r = 0; r < 16; ++r) { acc[0][r] = 0.f; acc[1][r] = 0.f; }
      if (ib * 32 < valid) {
        const u16* b0p = vnT + (ch * 64 + l31) * VSTR + hi * 8;
#pragma unroll
        for (int s2 = 0; s2 < 8; ++s2) {
          if (s2 < ns) {
            const bf16x8 b0 = *(const bf16x8*)(b0p + s2 * 16), b1 = *(const bf16x8*)(b0p + 32 * VSTR + s2 * 16);
            acc[0] = MFMA32(wa[s2], b0, acc[0]);
            acc[1] = MFMA32(wa[s2], b1, acc[1]);
          }
        }
      }
      if (g + 1 < g_hi) LOAD_W(g + 1);
      __syncthreads();
      float* Cs = (float*)lds;
#pragma unroll
      for (int nb2 = 0; nb2 < 2; ++nb2)
#pragma unroll
        for (int r = 0; r < 16; ++r)
          Cs[(ib * 32 + (r & 3) + 8 * (r >> 2) + 4 * hi) * CST + ch * 64 + nb2 * 32 + l31] = acc[nb2][r];
      __syncthreads();
#pragma unroll
      for (int i2 = 0; i2 < 8; ++i2) {
        const int idx = tid_g + NTHREADS * i2, row = idx >> 5, c = (idx & 31) * 4;
        if (row < valid) {
          const size_t tk = (size_t)(tokb + row);
          const float4 sv = *(const float4*)(Cs + row * CST + c);
          const float bb = bbv[i2];
          const uint2 u2 = uu[i2];
          uint2 ov;
          ov.x = pack2(bf2f((u16)(u2.x & 0xffff)) * (sv.x + bb), bf2f((u16)(u2.x >> 16)) * (sv.y + bb));
          ov.y = pack2(bf2f((u16)(u2.y & 0xffff)) * (sv.z + bb), bf2f((u16)(u2.y >> 16)) * (sv.w + bb));
          *(uint2*)(Mo + tk * 1024 + g * 128 + c) = ov;
        }
      }
      if (g + 1 < g_hi) LOAD_U(g + 1);
      __syncthreads();
    }
#undef LOAD_V
#undef LOAD_W
#undef LOAD_U
  }
}

#define XB_TMO      128
#define XB_XCNT(j)  (256  + 64 * (j))
#define XB_XSUB(j)  (1280 + 64 * (j))
#define XB_XGEN(j)  (2304 + 64 * (j))
#define XB_TOP      3328
#define XB_TOPGEN   3392
#define XCD_BAR_WORDS 3456
#define XB_SPIN_CAP (1u << 18)
#define LAS __attribute__((address_space(3)))
DI unsigned xb_ld(unsigned* p)              { return __hip_atomic_load(p, __ATOMIC_RELAXED, __HIP_MEMORY_SCOPE_AGENT); }
DI unsigned xb_add(unsigned* p, unsigned v) { return __hip_atomic_fetch_add(p, v, __ATOMIC_RELAXED, __HIP_MEMORY_SCOPE_AGENT); }
DI unsigned xb_xcc_id() { return (unsigned)__builtin_amdgcn_s_getreg((3 << 11) | 20) & 0xFu; }
#define XB_SPIN(cond, bar) do { unsigned _sp = 0; while (cond) { __builtin_amdgcn_s_sleep(1); \
    if ((++_sp & 255u) == 0u) { if (xb_ld(&(bar)[XB_TMO])) break; if (_sp > XB_SPIN_CAP) { atomicAdd(&(bar)[XB_TMO], 1u); break; } } } } while (0)
struct XcdBarrier { unsigned* bar; unsigned x; volatile LAS unsigned* st; };
DI XcdBarrier xcd_barrier_post(unsigned* bar, volatile LAS unsigned* st) {
  XcdBarrier b; b.bar = bar; b.x = xb_xcc_id(); b.st = st;
  if (threadIdx.x == 0) (void)xb_add(&bar[XB_XCNT(b.x)], 1u);
  return b;
}
DI void xcd_barrier_complete(unsigned* bar, unsigned x, unsigned& nloc, unsigned& nx) {
  const unsigned G = gridDim.x * gridDim.y * gridDim.z;
  unsigned sum, cnt, mine, sp = 0u;
  for (;;) {
    sum = 0u; cnt = 0u; mine = 0u;
#pragma unroll
    for (unsigned j = 0; j < 16; ++j) { const unsigned c = xb_ld(&bar[XB_XCNT(j)]); sum += c; cnt += (c > 0u) ? 1u : 0u; mine = (j == x) ? c : mine; }
    if (sum == G) break;
    __builtin_amdgcn_s_sleep(1);
    if ((++sp & 255u) == 0u) { if (xb_ld(&bar[XB_TMO])) break; if (sp > XB_SPIN_CAP) { atomicAdd(&bar[XB_TMO], 1u); break; } }
  }
  nloc = mine > 0u ? mine : 1u; nx = cnt > 0u ? cnt : 1u;
}
DI void xcd_barrier(const XcdBarrier& b) {
  asm volatile("s_waitcnt vmcnt(0)" ::: "memory");
  __syncthreads();
  if (threadIdx.x == 0) {
    unsigned* bar = b.bar;
    __builtin_amdgcn_s_waitcnt(0);
    unsigned nloc = b.st[0], nx = b.st[1];
    if (nloc == 0u) { xcd_barrier_complete(bar, b.x, nloc, nx); b.st[0] = nloc; b.st[1] = nx; }
    const unsigned old = xb_add(&bar[XB_XSUB(b.x)], 1u);
    const unsigned gen = old / nloc;
    if (old + 1u == (gen + 1u) * nloc) {
      __builtin_amdgcn_fence(__ATOMIC_RELEASE, "agent");
      asm volatile("s_waitcnt vmcnt(0)" ::: "memory");
      const unsigned og = xb_add(&bar[XB_TOP], 1u);
      const unsigned tg = og / nx;
      if (og + 1u == (tg + 1u) * nx) xb_add(&bar[XB_TOPGEN], 1u);
      else XB_SPIN(xb_ld(&bar[XB_TOPGEN]) == tg, bar);
      __builtin_amdgcn_fence(__ATOMIC_ACQUIRE, "agent");
      xb_add(&bar[XB_XGEN(b.x)], 1u);
      asm volatile("s_waitcnt vmcnt(0)" ::: "memory");
    } else {
      XB_SPIN(xb_ld(&bar[XB_XGEN(b.x)]) == gen, bar);
      __builtin_amdgcn_fence(__ATOMIC_ACQUIRE, "agent");
      asm volatile("s_waitcnt vmcnt(0)" ::: "memory");
    }
  }
  __syncthreads();
}

constexpr int NPHASES = 18;
DI void run_phase(const PV& p, Blk B, int ph, unsigned char* lds, int tid) {
  if (ph == 0) { phase_prologue(p, B, lds, tid); return; }
  if (ph == 17) { phase_norm(p, B, 0, true, tid); return; }
  const int l = (ph - 1) >> 2, s = (ph - 1) & 3;
  if (s == 0) phase_norm(p, B, l, false, tid);
  else if (s == 1) { if (l & 1) phase_gemm_odd_in(p, B, l >> 1, lds, tid); else phase_gemm_even_in(p, B, l >> 1, lds, tid); }
  else if (s == 2) { if (l & 1) phase_sgu(p, B, l >> 1, lds, tid); else phase_attn(p, B, l >> 1, lds, tid); }
  else phase_gemm_out(p, B, l, lds, tid);
}

template <bool COOP>
__global__ void __launch_bounds__(NTHREADS) mk_fwd(Params p, int ph_lo, int ph_hi) {
  extern __shared__ __attribute__((aligned(16))) unsigned char lds[];
  XcdBarrier xbar; xbar.bar = nullptr; xbar.x = 0; xbar.st = nullptr;
  if (COOP) {
    volatile LAS unsigned* st = (volatile LAS unsigned*)(LAS unsigned char*)(lds + LDS_BYTES - 32);
    if (threadIdx.x == 0) { st[0] = 0u; st[1] = 0u; }
    __syncthreads();
    xbar = xcd_barrier_post((unsigned*)(p.ws + WS_BAR), st);
  }
  for (int ph = ph_lo; ph < ph_hi; ++ph) {
    int t2 = threadIdx.x;
    Blk B; B.bid = blockIdx.x; B.nb = gridDim.x;
    PV q; q.k = (kaptr)__builtin_amdgcn_kernarg_segment_ptr();
    asm volatile("" : "+v"(t2), "+s"(B.bid), "+s"(B.nb), "+s"(q.k));
    run_phase(q, B, ph, lds, t2);
#if REPEAT_KINDS
    {
      const int sk = (ph - 1) & 3, lk = (ph - 1) >> 2;
      bool again = false;
      if (ph >= 1 && ph <= 16) {
        if (sk == 1 && (REPEAT_KINDS & 1)) again = true;
        if (sk == 2 && !(lk & 1) && (REPEAT_KINDS & 2)) again = true;
        if (sk == 2 && (lk & 1) && (REPEAT_KINDS & 4)) again = true;
        if (sk == 0 && (REPEAT_KINDS & 8)) again = true;
      }
      if (again) { __syncthreads(); run_phase(q, B, ph, lds, t2); }
    }
#endif
    if (COOP) { if (ph + 1 < ph_hi) { if (ph == 0) cg::this_grid().sync(); else xcd_barrier(xbar); } }
  }
}

template <int KIND>
__global__ void __launch_bounds__(NTHREADS) k_phase(Params p, int a) {
  extern __shared__ __attribute__((aligned(16))) unsigned char lds[];
  const int tid = threadIdx.x;
  Blk B; B.bid = blockIdx.x; B.nb = gridDim.x;
  PV q; q.k = (kaptr)__builtin_amdgcn_kernarg_segment_ptr();
  if (KIND == 0) phase_prologue(q, B, lds, tid);
  else if (KIND == 1) phase_norm(q, B, a, false, tid);
  else if (KIND == 2) phase_gemm_even_in(q, B, a, lds, tid);
  else if (KIND == 3) phase_gemm_odd_in(q, B, a, lds, tid);
  else if (KIND == 4) phase_attn(q, B, a, lds, tid);
  else if (KIND == 5) phase_sgu(q, B, a, lds, tid);
  else if (KIND == 6) phase_gemm_out(q, B, a, lds, tid);
  else phase_norm(q, B, 0, true, tid);
}
template <int KIND>
static void launch_phase(const Params& p, int a, int grid, hipStream_t stream) {
  static bool attr_set = false;
  if (!attr_set) { (void)hipFuncSetAttribute((const void*)k_phase<KIND>, hipFuncAttributeMaxDynamicSharedMemorySize, LDS_BYTES); attr_set = true; }
  hipLaunchKernelGGL(k_phase<KIND>, dim3(grid), dim3(NTHREADS), LDS_BYTES, stream, p, a);
}

extern "C" void kernel_launch(void* const* d_in, const int* in_sizes, int n_in, void* d_out, int out_size, void* d_ws, size_t ws_size, hipStream_t stream) {
  static int grid = 0;
  if (grid == 0) {
    if (ws_size < WS_END) { fprintf(stderr, "kernel_launch: workspace too small: %zu < %zu\n", ws_size, (size_t)WS_END); grid = -1; return; }
    int dev = 0, cus = 0, per_cu = 0;
    (void)hipGetDevice(&dev);
    (void)hipDeviceGetAttribute(&cus, hipDeviceAttributeMultiprocessorCount, dev);
#if ONE_LAUNCH
    (void)hipFuncSetAttribute((const void*)mk_fwd<true>, hipFuncAttributeMaxDynamicSharedMemorySize, LDS_BYTES);
    (void)hipOccupancyMaxActiveBlocksPerMultiprocessor(&per_cu, (const void*)mk_fwd<true>, NTHREADS, LDS_BYTES);
#else
    per_cu = 1;
#endif
    if (per_cu < 1) { fprintf(stderr, "kernel_launch: occupancy query gave %d\n", per_cu); grid = -1; return; }
    grid = cus * per_cu;
    if (grid > MAXGRID) grid = MAXGRID;
  }
  if (grid < 0) return;
  Params p{};
  for (int i = 0; i < 21; ++i) p.in[i] = (const float*)d_in[i];
  p.out = (float*)d_out;
  p.ws = (unsigned char*)d_ws;
#if ONE_LAUNCH
  (void)hipMemsetAsync((unsigned char*)d_ws + WS_BAR, 0, XCD_BAR_BYTES, stream);
  int lo = 0, hi = NPHASES;
  void* args[] = {&p, &lo, &hi};
  hipError_t e = hipLaunchCooperativeKernel((const void*)mk_fwd<true>, dim3(grid), dim3(NTHREADS), args, LDS_BYTES, stream);
  if (e != hipSuccess) fprintf(stderr, "cooperative launch failed: %s (grid %d)\n", hipGetErrorString(e), grid);
#else
  launch_phase<0>(p, 0, grid, stream);
  for (int l = 0; l < 4; ++l) {
    launch_phase<1>(p, l, grid, stream);
    if (l & 1) { launch_phase<3>(p, l >> 1, grid, stream); launch_phase<5>(p, l >> 1, grid, stream); }
    else { launch_phase<2>(p, l >> 1, grid, stream); launch_phase<4>(p, l >> 1, grid, stream); }
    launch_phase<6>(p, l, grid, stream);
  }
  launch_phase<7>(p, 0, grid, stream);
#endif
}
```
